# Optimizing an MI355X kernel written in HIP

```python
import jax, jax.numpy as jnp
from jax import lax
import numpy as np

D_MODEL = 2048
BATCH = 4
SEQ = 2048
DEPTH = 1
DEC_BATCH = 128
DEC_SEQ = 1
PAST_LEN = 16384
PAGE_SIZE = 128

D_CONV = D_MODEL // 2
CONV_WIDTH = 3
D_HGRN = D_MODEL // 2
HGRN_KDIM = 128
HGRN_HEADS = D_HGRN // HGRN_KDIM
HGRN_VDIM = D_HGRN // HGRN_HEADS
CHUNK = 64
D_FF = 4 * D_MODEL
EPS = 1e-6
IN_SIZES = (D_CONV, D_CONV, D_CONV, D_HGRN, D_HGRN, D_HGRN, D_HGRN, D_MODEL, D_MODEL)
N_IN = sum(IN_SIZES)

kernel_name = "hybrid_shortconv_hgrn2_gated_merge_step"


def rmsnorm(x, g):
    xf = x.astype(jnp.float32)
    y = xf * lax.rsqrt(jnp.mean(xf * xf, axis=-1, keepdims=True) + EPS)
    return (y * g.astype(jnp.float32)).astype(x.dtype)


def hgrn2_chunked(q, k, v, log_f, s0):
    bn, t, h, _ = q.shape
    dv = v.shape[-1]
    L = min(CHUNK, t)
    pad = (-t) % L

    def prep(a):
        a = jnp.pad(a.astype(jnp.float32), ((0, 0), (0, pad), (0, 0), (0, 0)))
        return a.reshape(bn, -1, L, h, a.shape[-1]).transpose(0, 3, 1, 2, 4)

    qc, kc, vc, lf = prep(q), prep(k), prep(v), prep(log_f)
    b = jnp.cumsum(lf, axis=3)
    q_in = qc * jnp.exp(b)
    k_in = kc * jnp.exp(-b)
    scores = jnp.einsum('bhnld,bhnsd->bhnls', q_in, k_in)
    causal = jnp.tril(jnp.ones((L, L), dtype=bool))
    scores = jnp.where(causal, scores, 0.0)
    o_intra = jnp.einsum('bhnls,bhnse->bhnle', scores, vc)
    b_last = b[:, :, :, -1:, :]
    k_end = kc * jnp.exp(b_last - b)
    delta = jnp.einsum('bhnld,bhnle->nbhde', k_end, vc)
    decay = jnp.exp(b_last[:, :, :, 0, :]).transpose(2, 0, 1, 3)

    def step(S, inp):
        dec, dl = inp
        return dec[..., None] * S + dl, S

    s_fin, s_starts = lax.scan(step, s0.astype(jnp.float32), (decay, delta))
    o_inter = jnp.einsum('bhnld,nbhde->bhnle', q_in, s_starts)
    o = (o_intra + o_inter).transpose(0, 2, 3, 1, 4).reshape(bn, -1, h, dv)[:, :t]
    return o, s_fin


def layer(x, conv_state, hgrn_state, lb, norm_mix, w_in, conv_w, onorm_g,
          w_branch_a, w_branch_b, w_out, norm_ffn, w_up, w_down):
    bn, t, _ = x.shape
    hx = rmsnorm(x, norm_mix)
    proj = hx @ w_in
    cuts = [int(c) for c in np.cumsum(IN_SIZES)[:-1]]
    hc, bg, cg, q, fz, iv, og, ga, gb = jnp.split(proj, cuts, axis=-1)

    u = cg * hc
    buf = jnp.concatenate([conv_state.astype(u.dtype), u], axis=1)
    conv = conv_w[0] * buf[:, :t] + conv_w[1] * buf[:, 1:t + 1] + conv_w[2] * buf[:, 2:t + 2]
    a = bg * conv
    new_conv = buf[:, t:]

    f = lb + (1.0 - lb) * jax.nn.sigmoid(fz.astype(jnp.float32))
    log_f = jnp.log(f)
    kk = 1.0 - f
    shp = (bn, t, HGRN_HEADS, HGRN_KDIM)
    o, s_new = hgrn2_chunked(jax.nn.silu(q).reshape(shp), kk.reshape(shp),
                             iv.reshape(bn, t, HGRN_HEADS, HGRN_VDIM), log_f.reshape(shp),
                             hgrn_state)
    o = rmsnorm(o.astype(x.dtype), onorm_g) * jax.nn.silu(og.reshape(bn, t, HGRN_HEADS, HGRN_VDIM))
    o = o.reshape(bn, t, D_HGRN)

    mix = jax.nn.sigmoid(ga) * (a @ w_branch_a) + jax.nn.sigmoid(gb) * (o @ w_branch_b)
    x = x + mix @ w_out

    h2 = rmsnorm(x, norm_ffn)
    x = x + jnp.square(jax.nn.relu(h2 @ w_up)) @ w_down
    return x, new_conv, s_new.astype(hgrn_state.dtype)


def setup_inputs(seed: int = 0) -> dict:
    key = jax.random.key(seed)
    ks = jax.random.split(key, 16)
    f32 = jnp.float32
    nrm = lambda k, s, sc: jax.random.normal(k, s, f32) * sc
    return {
        "x_prompt": nrm(ks[0], (BATCH, SEQ, D_MODEL), 1.0),
        "x_sample": nrm(ks[1], (DEC_BATCH, DEC_SEQ, D_MODEL), 1.0),
        "state_conv": nrm(ks[2], (DEPTH, DEC_BATCH, CONV_WIDTH - 1, D_CONV), 1.0),
        "state_hgrn": nrm(ks[3], (DEPTH, DEC_BATCH, HGRN_HEADS, HGRN_KDIM, HGRN_VDIM), 1.0),
        "norm_mix": 1.0 + nrm(ks[4], (DEPTH, D_MODEL), 0.02),
        "w_in": nrm(ks[5], (DEPTH, D_MODEL, N_IN), D_MODEL ** -0.5),
        "conv_w": nrm(ks[6], (DEPTH, CONV_WIDTH, D_CONV), CONV_WIDTH ** -0.5),
        "lb_logits": nrm(ks[7], (DEPTH + 1, D_HGRN), 0.1),
        "onorm_g": 1.0 + nrm(ks[8], (DEPTH, HGRN_VDIM), 0.02),
        "w_branch_a": nrm(ks[9], (DEPTH, D_CONV, D_MODEL), D_CONV ** -0.5),
        "w_branch_b": nrm(ks[10], (DEPTH, D_HGRN, D_MODEL), D_HGRN ** -0.5),
        "w_out": nrm(ks[11], (DEPTH, D_MODEL, D_MODEL), D_MODEL ** -0.5),
        "norm_ffn": 1.0 + nrm(ks[12], (DEPTH, D_MODEL), 0.02),
        "w_up": nrm(ks[13], (DEPTH, D_MODEL, D_FF), D_MODEL ** -0.5),
        "w_down": nrm(ks[14], (DEPTH, D_FF, D_MODEL), D_FF ** -0.5),
        "norm_final": 1.0 + nrm(ks[15], (D_MODEL,), 0.02),
    }


def reference(x_prompt, x_sample, state_conv, state_hgrn, norm_mix, w_in, conv_w,
              lb_logits, onorm_g, w_branch_a, w_branch_b, w_out, norm_ffn, w_up,
              w_down, norm_final):
    lb_all = jnp.cumsum(jax.nn.softmax(lb_logits.astype(jnp.float32), axis=0), axis=0)
    yp, ys = x_prompt, x_sample
    conv_p, hgrn_p, conv_s, hgrn_s = [], [], [], []
    for l in range(DEPTH):
        params = (lb_all[l], norm_mix[l], w_in[l], conv_w[l], onorm_g[l], w_branch_a[l],
                  w_branch_b[l], w_out[l], norm_ffn[l], w_up[l], w_down[l])
        zc = jnp.zeros((yp.shape[0], CONV_WIDTH - 1, D_CONV), yp.dtype)
        zh = jnp.zeros((yp.shape[0], HGRN_HEADS, HGRN_KDIM, HGRN_VDIM), yp.dtype)
        yp, c, s = layer(yp, zc, zh, *params)
        conv_p.append(c)
        hgrn_p.append(s)
        ys, c, s = layer(ys, state_conv[l], state_hgrn[l], *params)
        conv_s.append(c)
        hgrn_s.append(s)
    yp = rmsnorm(yp, norm_final)
    ys = rmsnorm(ys, norm_final)
    return (yp, ys, jnp.stack(conv_p), jnp.stack(hgrn_p), jnp.stack(conv_s), jnp.stack(hgrn_s))
```

```cpp
#include <hip/hip_runtime.h>
#include <hip/hip_cooperative_groups.h>
#include <cstdio>
#include <cstdint>
namespace cg = cooperative_groups;
namespace pg8 {
#define PG8_LAS __attribute__((address_space(3)))
typedef unsigned short bf16_t;
#define MFMA_SETTLE() asm volatile("s_nop 7\n\ts_nop 7\n\ts_nop 7" ::: "memory")
typedef short bf16x8 __attribute__((ext_vector_type(8)));
typedef float f32x4 __attribute__((ext_vector_type(4)));
typedef unsigned u32x4 __attribute__((ext_vector_type(4)));
constexpr int BM = 256, BK = 64, HALF = 128, HTB = HALF * BK * 2  , STAGE_BYTES = 8 * HTB, NXCD = 8, WGM = 8;

__host__ __device__ __forceinline__ int lds_byte(int r, int c) { const int st = (r >> 4) * 2 + (c >> 5), rr = r & 15, cc = c & 31, ob = rr * 64 + cc * 2; return st * 1024 + (ob ^ (((ob >> 9) & 1) << 5)); }
__host__ __device__ __forceinline__ void stage_rc(int b, int& R, int& C) { const int st = b / 1024, sb = b % 1024, swz = sb ^ (((sb >> 9) & 1) << 5); R = (st >> 1) * 16 + swz / 64; C = (st & 1) * 32 + (swz % 64) / 2; }
__host__ __device__ __forceinline__ int perm32(int rho) { const int n = rho >> 4, i = rho & 15; return 8 * (i >> 2) + 4 * n + (i & 3); }

struct Unit { int pm, pn; };
struct Gemm { const bf16_t* A; const bf16_t* Bt; int M, N, K; };

struct StaticOrder {
    int nM, nN, nwg, G, c, wgm;
    __host__ __device__ void init(int M, int N, int G_, int c_, int wgm_ = WGM) { nM = M / BM; nN = N / BM; nwg = nM * nN; G = G_; c = c_; wgm = wgm_; }
    __host__ __device__ bool next(int i, Unit& u) const {
        const long L = (long)i * G + c; if (L >= nwg) return false;
        int wgid = (int)L; { const int q = nwg / NXCD, r = nwg % NXCD, xcd = wgid % NXCD, off = wgid / NXCD; wgid = (xcd < r ? xcd * (q + 1) : r * (q + 1) + (xcd - r) * q) + off; }
        const int nig = wgm * nN, gid = wgid / nig, fm = gid * wgm, gsz = (nM - fm) < wgm ? (nM - fm) : wgm;
        u.pm = fm + ((wgid % nig) % gsz); u.pn = (wgid % nig) / gsz; return true;
    }
    __device__ __forceinline__ void a_ready(const Unit&) const {}
    __device__ __forceinline__ void done(const Unit&) const {}
};

__device__ __forceinline__ unsigned cvt_pk_bf16(float lo, float hi) { unsigned r; asm volatile("v_cvt_pk_bf16_f32 %0, %1, %2" : "=v"(r) : "v"(lo), "v"(hi)); return r; }
__device__ __forceinline__ u32x4 pack8(const f32x4 a, const f32x4 b) { u32x4 w; w.x = cvt_pk_bf16(a[0], a[1]); w.y = cvt_pk_bf16(a[2], a[3]); w.z = cvt_pk_bf16(b[0], b[1]); w.w = cvt_pk_bf16(b[2], b[3]); return w; }
__device__ __forceinline__ float bf_lo(unsigned w) { return __uint_as_float(w << 16); }
__device__ __forceinline__ float bf_hi(unsigned w) { return __uint_as_float(w & 0xffff0000u); }
__device__ __forceinline__ void unpack8(const u32x4 w, f32x4& a, f32x4& b) { a = (f32x4){bf_lo(w.x), bf_hi(w.x), bf_lo(w.y), bf_hi(w.y)}; b = (f32x4){bf_lo(w.z), bf_hi(w.z), bf_lo(w.w), bf_hi(w.w)}; }
__device__ __forceinline__ float sigm(float x) { return __builtin_amdgcn_rcpf(1.0f + __expf(-x)); }
constexpr int MP = 8448, MPROMPT = 8192, MTOT = 8320;
struct EpiG1 {
    static constexpr bool PERM = true, AFTER_DRAIN = false, HAS_MID = false;
    bf16_t *U, *BG, *Q, *IV, *OG, *R, *GBS; float* LOGF; const float* lbl; float* ncp; float* ncs;
    __device__ __forceinline__ void mid(f32x4 (&)[2][2][4][2], const Unit&, int, int, int, int) const {}
    __device__ __forceinline__ void operator()(const f32x4 (&acc)[2][2][4][2], const Unit& u, int wr, int wc, int fr, int fq) const {
        const int pn = u.pn, row0 = u.pm * BM + wr * 64 + fr, cin = wc * 32 + 8 * fq;
        if (pn < 8) {
            const int col = 128 * pn + cin;
#pragma unroll
            for (int ai = 0; ai < 2; ++ai)
#pragma unroll
                for (int m = 0; m < 4; ++m) {
                    const int row = row0 + ai * HALF + m * 16;
                    const f32x4 v0 = acc[ai][0][m][0] * acc[ai][1][m][0], v1 = acc[ai][0][m][1] * acc[ai][1][m][1];
                    *(u32x4*)(U + (size_t)row * 1024 + col) = pack8(v0, v1);
                    if (row < MPROMPT) { const int t = row & 2047; if (t >= 2046) { float* p = ncp + ((size_t)((row >> 11) * 2 + (t - 2046))) * 1024 + col; *(f32x4*)p = v0; *(f32x4*)(p + 4) = v1; } }
                    else if (row < MTOT) { float* p = ncs + ((size_t)((row - MPROMPT) * 2 + 1)) * 1024 + col; *(f32x4*)p = v0; *(f32x4*)(p + 4) = v1; }
                }
        } else if (pn < 28) {
            const int ty = (pn - 8) >> 2, cb = ((pn - 8) & 3) * 256;
#pragma unroll
            for (int bj = 0; bj < 2; ++bj) {
                const int col = cb + bj * HALF + cin;
                f32x4 lb0 = (f32x4){0.f, 0.f, 0.f, 0.f}, lb1 = lb0;
                if (ty == 2) {
                    const f32x4 a0 = *(const f32x4*)(lbl + col), a1 = *(const f32x4*)(lbl + col + 4), b0 = *(const f32x4*)(lbl + 1024 + col), b1 = *(const f32x4*)(lbl + 1024 + col + 4);
#pragma unroll
                    for (int i = 0; i < 4; ++i) { lb0[i] = sigm(a0[i] - b0[i]); lb1[i] = sigm(a1[i] - b1[i]); }
                }
#pragma unroll
                for (int ai = 0; ai < 2; ++ai)
#pragma unroll
                    for (int m = 0; m < 4; ++m) {
                        const int row = row0 + ai * HALF + m * 16;
                        f32x4 v0 = acc[ai][bj][m][0], v1 = acc[ai][bj][m][1];
                        if (ty == 2) {
#pragma unroll
                            for (int i = 0; i < 4; ++i) { v0[i] = __logf(lb0[i] + (1.0f - lb0[i]) * sigm(v0[i])); v1[i] = __logf(lb1[i] + (1.0f - lb1[i]) * sigm(v1[i])); }
                            float* p = LOGF + (size_t)row * 1024 + col; *(f32x4*)p = v0; *(f32x4*)(p + 4) = v1;
                        } else {
                            if (ty == 1 || ty == 4) {
#pragma unroll
                                for (int i = 0; i < 4; ++i) { v0[i] = v0[i] * sigm(v0[i]); v1[i] = v1[i] * sigm(v1[i]); }
                            }
                            bf16_t* base = ty == 0 ? BG : (ty == 1 ? Q : (ty == 3 ? IV : OG));
                            *(u32x4*)(base + (size_t)row * 1024 + col) = pack8(v0, v1);
                        }
                    }
            }
        } else {
            const int col = 128 * (pn - 28) + cin;
#pragma unroll
            for (int ai = 0; ai < 2; ++ai)
#pragma unroll
                for (int m = 0; m < 4; ++m) {
                    const int row = row0 + ai * HALF + m * 16;
                    f32x4 r0, r1, g0, g1;
#pragma unroll
                    for (int i = 0; i < 4; ++i) {
                        const float ea0 = __expf(-acc[ai][0][m][0][i]), eb0 = __expf(-acc[ai][1][m][0][i]), ea1 = __expf(-acc[ai][0][m][1][i]), eb1 = __expf(-acc[ai][1][m][1][i]);
                        g0[i] = __builtin_amdgcn_rcpf(1.0f + eb0); g1[i] = __builtin_amdgcn_rcpf(1.0f + eb1);
                        r0[i] = (1.0f + eb0) * __builtin_amdgcn_rcpf(1.0f + ea0); r1[i] = (1.0f + eb1) * __builtin_amdgcn_rcpf(1.0f + ea1);
                    }
                    *(u32x4*)(R + (size_t)row * 2048 + col) = pack8(r0, r1);
                    *(u32x4*)(GBS + (size_t)row * 2048 + col) = pack8(g0, g1);
                }
        }
    }
};
struct EpiG2 {
    static constexpr bool PERM = true, AFTER_DRAIN = false, HAS_MID = true;
    const bf16_t *R, *GBS; bf16_t* MIX;
    __device__ __forceinline__ void mid(f32x4 (&acc)[2][2][4][2], const Unit& u, int wr, int wc, int fr, int fq) const {
        int row0 = u.pm * BM + wr * 64 + fr, col0 = u.pn * BM + wc * 32 + 8 * fq;
        asm volatile("" : "+v"(row0), "+v"(col0));
#pragma unroll
        for (int ai = 0; ai < 2; ++ai) {
            u32x4 w[4][2];
#pragma unroll
            for (int m = 0; m < 4; ++m)
#pragma unroll
                for (int bj = 0; bj < 2; ++bj) w[m][bj] = *(const u32x4*)(R + (size_t)(row0 + ai * HALF + m * 16) * 2048 + col0 + bj * HALF);
#pragma unroll
            for (int m = 0; m < 4; ++m)
#pragma unroll
                for (int bj = 0; bj < 2; ++bj) { f32x4 a, b; unpack8(w[m][bj], a, b); acc[ai][bj][m][0] *= a; acc[ai][bj][m][1] *= b; }
            asm volatile("" ::: "memory");
        }
    }
    __device__ __forceinline__ void operator()(const f32x4 (&acc)[2][2][4][2], const Unit& u, int wr, int wc, int fr, int fq) const {
        const int row0 = u.pm * BM + wr * 64 + fr, col0 = u.pn * BM + wc * 32 + 8 * fq;
#pragma unroll
        for (int ai = 0; ai < 2; ++ai) {
            u32x4 gw[4][2];
#pragma unroll
            for (int m = 0; m < 4; ++m)
#pragma unroll
                for (int bj = 0; bj < 2; ++bj) gw[m][bj] = *(const u32x4*)(GBS + (size_t)(row0 + ai * HALF + m * 16) * 2048 + col0 + bj * HALF);
#pragma unroll
            for (int m = 0; m < 4; ++m)
#pragma unroll
                for (int bj = 0; bj < 2; ++bj) {
                    const size_t off = (size_t)(row0 + ai * HALF + m * 16) * 2048 + col0 + bj * HALF;
                    f32x4 a, b; unpack8(gw[m][bj], a, b);
                    *(u32x4*)(MIX + off) = pack8(acc[ai][bj][m][0] * a, acc[ai][bj][m][1] * b);
                }
        }
    }
};
struct EpiG3 {
    static constexpr bool PERM = true, AFTER_DRAIN = false, HAS_MID = false;
    const float* X; bf16_t* X1B; bf16_t* A3; const float* g; float* ss;
    __device__ __forceinline__ void mid(f32x4 (&)[2][2][4][2], const Unit&, int, int, int, int) const {}
    __device__ __forceinline__ void operator()(const f32x4 (&acc)[2][2][4][2], const Unit& u, int wr, int wc, int fr, int fq) const {
        const int row0 = u.pm * BM + wr * 64 + fr, col0 = u.pn * BM + wc * 32 + 8 * fq;
#pragma unroll
        for (int ai = 0; ai < 2; ++ai) {
            f32x4 xa[4][2][2];
#pragma unroll
            for (int m = 0; m < 4; ++m)
#pragma unroll
                for (int bj = 0; bj < 2; ++bj) { const float* xp = X + (size_t)(row0 + ai * HALF + m * 16) * 2048 + col0 + bj * HALF; xa[m][bj][0] = *(const f32x4*)xp; xa[m][bj][1] = *(const f32x4*)(xp + 4); }
#pragma unroll
            for (int m = 0; m < 4; ++m) {
                const int row = row0 + ai * HALF + m * 16; float s = 0.f;
#pragma unroll
                for (int bj = 0; bj < 2; ++bj) {
                    const size_t off = (size_t)row * 2048 + col0 + bj * HALF;
                    const f32x4 x0 = xa[m][bj][0] + acc[ai][bj][m][0], x1 = xa[m][bj][1] + acc[ai][bj][m][1];
                    *(u32x4*)(X1B + off) = pack8(x0, x1);
                    s += (x0[0] * x0[0] + x0[1] * x0[1]) + (x0[2] * x0[2] + x0[3] * x0[3]) + (x1[0] * x1[0] + x1[1] * x1[1]) + (x1[2] * x1[2] + x1[3] * x1[3]);
                }
                s += __shfl_xor(s, 16); s += __shfl_xor(s, 32);
                if (fq == 0) atomicAdd(ss + row, s);
            }
        }
    }
};
struct EpiUp {
    static constexpr bool PERM = true, AFTER_DRAIN = false, HAS_MID = false;
    bf16_t* H; const float* ss;
    __device__ __forceinline__ void mid(f32x4 (&)[2][2][4][2], const Unit&, int, int, int, int) const {}
    __device__ __forceinline__ void operator()(const f32x4 (&acc)[2][2][4][2], const Unit& u, int wr, int wc, int fr, int fq) const {
        const int row0 = u.pm * BM + wr * 64 + fr, col0 = u.pn * BM + wc * 32 + 8 * fq;
        float rsv[2][4];
#pragma unroll
        for (int ai = 0; ai < 2; ++ai)
#pragma unroll
            for (int m = 0; m < 4; ++m) rsv[ai][m] = ss[row0 + ai * HALF + m * 16];
#pragma unroll
        for (int ai = 0; ai < 2; ++ai)
#pragma unroll
            for (int m = 0; m < 4; ++m) {
                const int row = row0 + ai * HALF + m * 16;
                const float rs = __builtin_amdgcn_rsqf(rsv[ai][m] * (1.0f / 2048.0f) + 1e-6f);
#pragma unroll
                for (int bj = 0; bj < 2; ++bj) {
                    f32x4 v0 = acc[ai][bj][m][0] * rs, v1 = acc[ai][bj][m][1] * rs;
#pragma unroll
                    for (int i = 0; i < 4; ++i) { const float a = fmaxf(v0[i], 0.f), b = fmaxf(v1[i], 0.f); v0[i] = a * a; v1[i] = b * b; }
                    *(u32x4*)(H + (size_t)row * 8192 + col0 + bj * HALF) = pack8(v0, v1);
                }
            }
    }
};
struct EpiDown {
    static constexpr bool PERM = true, AFTER_DRAIN = false, HAS_MID = false;
    float* X1; const bf16_t* X1B;
    __device__ __forceinline__ void mid(f32x4 (&)[2][2][4][2], const Unit&, int, int, int, int) const {}
    __device__ __forceinline__ void operator()(const f32x4 (&acc)[2][2][4][2], const Unit& u, int wr, int wc, int fr, int fq) const {
        const int row0 = u.pm * BM + wr * 64 + fr, col0 = u.pn * BM + wc * 32 + 8 * fq;
#pragma unroll
        for (int ai = 0; ai < 2; ++ai)
#pragma unroll
            for (int m = 0; m < 4; ++m)
#pragma unroll
                for (int bj = 0; bj < 2; ++bj) {
                    const size_t off = (size_t)(row0 + ai * HALF + m * 16) * 2048 + col0 + bj * HALF; float* p = X1 + off;
                    f32x4 b0, b1; unpack8(*(const u32x4*)(X1B + off), b0, b1);
                    const f32x4 x0 = b0 + acc[ai][bj][m][0], x1 = b1 + acc[ai][bj][m][1];
                    *(f32x4*)p = x0; *(f32x4*)(p + 4) = x1;
                }
    }
};
struct EpiDownLn {
    static constexpr bool PERM = true, AFTER_DRAIN = false, HAS_MID = false;
    float* X1; const bf16_t* X1B; const float* g; float* ss2; unsigned* cnt; PG8_LAS unsigned char* ldsx;
    __device__ __forceinline__ void mid(f32x4 (&)[2][2][4][2], const Unit&, int, int, int, int) const {}
    __device__ __forceinline__ void operator()(f32x4 (&acc)[2][2][4][2], const Unit& u, int wr, int wc, int fr, int fq) const {
        const int row0 = u.pm * BM + wr * 64 + fr, col0 = u.pn * BM + wc * 32 + 8 * fq;
#pragma unroll
        for (int ai = 0; ai < 2; ++ai)
#pragma unroll
            for (int m = 0; m < 4; ++m) {
                const int row = row0 + ai * HALF + m * 16; float s = 0.f;
#pragma unroll
                for (int bj = 0; bj < 2; ++bj) {
                    f32x4 b0, b1; unpack8(*(const u32x4*)(X1B + (size_t)row * 2048 + col0 + bj * HALF), b0, b1);
                    const f32x4 x0 = b0 + acc[ai][bj][m][0], x1 = b1 + acc[ai][bj][m][1];
                    acc[ai][bj][m][0] = x0; acc[ai][bj][m][1] = x1;
                    s += (x0[0] * x0[0] + x0[1] * x0[1]) + (x0[2] * x0[2] + x0[3] * x0[3]) + (x1[0] * x1[0] + x1[1] * x1[1]) + (x1[2] * x1[2] + x1[3] * x1[3]);
                }
                s += __shfl_xor(s, 16); s += __shfl_xor(s, 32);
                if (fq == 0) atomicAdd(ss2 + row, s);
            }
        asm volatile("s_waitcnt vmcnt(0)" ::: "memory");
        __builtin_amdgcn_s_barrier(); asm volatile("" ::: "memory");
        PG8_LAS float* RS = (PG8_LAS float*)(ldsx);
        unsigned* c = cnt + 64 * u.pm;
        if (threadIdx.x < 64) {
            if (threadIdx.x == 0) __hip_atomic_fetch_add(c, 1u, __ATOMIC_RELAXED, __HIP_MEMORY_SCOPE_AGENT);
            for (unsigned sp = 0; sp < (1u << 22); ++sp) {
                if ((unsigned)__builtin_amdgcn_readfirstlane(__hip_atomic_load(c, __ATOMIC_RELAXED, __HIP_MEMORY_SCOPE_AGENT)) >= 8u) break;
                __builtin_amdgcn_s_sleep(2);
            }
#pragma unroll
            for (int j = 0; j < 4; ++j) {
                const int r = (int)threadIdx.x * 4 + j;
                const float tot = __hip_atomic_fetch_add(ss2 + u.pm * BM + r, 0.0f, __ATOMIC_RELAXED, __HIP_MEMORY_SCOPE_AGENT);
                RS[r] = __builtin_amdgcn_rsqf(tot * (1.0f / 2048.0f) + 1e-6f);
            }
        }
        asm volatile("s_waitcnt vmcnt(0) lgkmcnt(0)" ::: "memory"); __builtin_amdgcn_s_barrier(); asm volatile("" ::: "memory");
        f32x4 gv[2][2];
#pragma unroll
        for (int bj = 0; bj < 2; ++bj) { gv[bj][0] = *(const f32x4*)(g + col0 + bj * HALF); gv[bj][1] = *(const f32x4*)(g + col0 + bj * HALF + 4); }
#pragma unroll
        for (int ai = 0; ai < 2; ++ai)
#pragma unroll
            for (int m = 0; m < 4; ++m) {
                const int row = row0 + ai * HALF + m * 16;
                const float rs = RS[wr * 64 + fr + ai * HALF + m * 16];
#pragma unroll
                for (int bj = 0; bj < 2; ++bj) {
                    float* p = X1 + (size_t)row * 2048 + col0 + bj * HALF;
                    *(f32x4*)p = acc[ai][bj][m][0] * rs * gv[bj][0]; *(f32x4*)(p + 4) = acc[ai][bj][m][1] * rs * gv[bj][1];
                }
            }
    }
};
template <class Epi, class Sched, bool ALIGN_EPI = false, bool SP2 = false>
__device__ __forceinline__ void gemm_phase(PG8_LAS unsigned char* lds, const Gemm g, const Sched& S, const Epi& E) {
    const int tid = threadIdx.x, wid = __builtin_amdgcn_readfirstlane(tid >> 6), lane = tid & 63, wr = wid >> 2, wc = wid & 3, fr = lane & 15, fq = lane >> 4;
    const int K = g.K, nt = K / BK;
    unsigned voffA[2], voffB[2];
#pragma unroll
    for (int i = 0; i < 2; ++i) { int R, C; stage_rc(tid * 16 + i * 8192, R, C); const int Rb = Epi::PERM ? ((R & ~31) + perm32(R & 31)) : R;
        voffA[i] = (unsigned)(R * K + C) * 2u; voffB[i] = (unsigned)(Rb * K + C) * 2u; }
    const size_t kstep = (size_t)(BK * 2);
    const size_t hstep = (size_t)HALF * K * 2;
    const size_t tstep = 2 * hstep;
    const unsigned ldsw = (unsigned)wid * 1024u;
    const int aoff = lds_byte(wr * 64 + fr, fq * 8), boff = lds_byte(wc * 32 + fr, fq * 8);
#define PG8_SA(b, h) (((b) * 2 + (h)) * HTB)
#define PG8_SB(b, h) ((4 + (b) * 2 + (h)) * HTB)
#define PG8_STAGE(bufoff, gbase, voff) do { _Pragma("unroll") for (int _i = 0; _i < 2; ++_i) \
        __builtin_amdgcn_global_load_lds((const unsigned*)((const char*)(gbase) + (voff)[_i]), (PG8_LAS unsigned*)(lds + (bufoff) + ldsw + _i * 8192), 16, 0, 0); } while (0)
#define PG8_LDA(dst, b, h) do { _Pragma("unroll") for (int m = 0; m < 4; ++m) _Pragma("unroll") for (int k = 0; k < 2; ++k) dst[m][k] = *(const PG8_LAS bf16x8*)(lds + PG8_SA(b, h) + aoff + m * 2048 + k * 1024); } while (0)
#define PG8_LDB(dst, b, h) do { _Pragma("unroll") for (int n = 0; n < 2; ++n) _Pragma("unroll") for (int k = 0; k < 2; ++k) dst[n][k] = *(const PG8_LAS bf16x8*)(lds + PG8_SB(b, h) + boff + n * 2048 + k * 1024); } while (0)
#define PG8_MMA(ai, bj, At, Bt) do { __builtin_amdgcn_s_setprio(1); _Pragma("unroll") for (int m = 0; m < 4; ++m) _Pragma("unroll") for (int n = 0; n < 2; ++n) _Pragma("unroll") for (int k = 0; k < 2; ++k) \
        acc[ai][bj][m][n] = __builtin_amdgcn_mfma_f32_16x16x32_bf16(Bt[n][k], At[m][k], acc[ai][bj][m][n], 0, 0, 0); __builtin_amdgcn_s_setprio(0); } while (0)
#define PG8_WAIT_V(n) asm volatile("s_waitcnt vmcnt(" #n ")" ::: "memory")
#define PG8_WAIT_L(n) asm volatile("s_waitcnt lgkmcnt(" #n ")" ::: "memory")
#define PG8_BAR __builtin_amdgcn_s_barrier()
#define PG8_SCHED __builtin_amdgcn_sched_barrier(0)
    Unit cur, nxt; int ui = 0;
    if (!S.next(0, cur)) return;
    f32x4 acc[2][2][4][2];
#pragma unroll
    for (int a = 0; a < 2; ++a)
#pragma unroll
        for (int b = 0; b < 2; ++b)
#pragma unroll
            for (int m = 0; m < 4; ++m)
#pragma unroll
                for (int n = 0; n < 2; ++n) acc[a][b][m][n] = (f32x4){0.f, 0.f, 0.f, 0.f};
    bf16x8 At[4][2], B0[2][2], B1[2][2];
    const char* cA = (const char*)g.A + (size_t)cur.pm * tstep; const char* cB = (const char*)g.Bt + (size_t)cur.pn * tstep;
    S.a_ready(cur);
    if constexpr (SP2) {
        PG8_STAGE(PG8_SB(0, 0), cB, voffB); PG8_STAGE(PG8_SB(0, 1), cB + hstep, voffB); PG8_STAGE(PG8_SA(0, 0), cA, voffA); PG8_STAGE(PG8_SA(0, 1), cA + hstep, voffA);
        if (wr == 1) PG8_BAR;
        PG8_WAIT_V(2); PG8_BAR;
        PG8_STAGE(PG8_SB(1, 0), cB + kstep, voffB); PG8_STAGE(PG8_SA(1, 0), cA + kstep, voffA); PG8_STAGE(PG8_SB(1, 1), cB + hstep + kstep, voffB);
        PG8_WAIT_V(6); PG8_BAR;
    } else {
        PG8_STAGE(PG8_SB(0, 0), cB, voffB); PG8_STAGE(PG8_SA(0, 0), cA, voffA); PG8_STAGE(PG8_SB(0, 1), cB + hstep, voffB); PG8_STAGE(PG8_SA(0, 1), cA + hstep, voffA);
        if (wr == 1) PG8_BAR;
        PG8_WAIT_V(4); PG8_BAR;
        PG8_STAGE(PG8_SB(1, 0), cB + kstep, voffB); PG8_STAGE(PG8_SA(1, 0), cA + kstep, voffA); PG8_STAGE(PG8_SB(1, 1), cB + hstep + kstep, voffB);
        PG8_WAIT_V(6); PG8_BAR;
    }
    for (;;) {
        const bool has_next = S.next(ui + 1, nxt);
        const char* nA = has_next ? (const char*)g.A + (size_t)nxt.pm * tstep : cA; const char* nB = has_next ? (const char*)g.Bt + (size_t)nxt.pn * tstep : cB;
        for (int t = 0; t < nt; t += 2) {
            const bool last = (t == nt - 2);
            if constexpr (Epi::HAS_MID) { if (t == (nt >> 1)) { MFMA_SETTLE(); E.mid(acc, cur, wr, wc, fr, fq); } }
            const char* a1 = cA + (size_t)(t + 1) * kstep;
            const char* a2 = last ? nA : cA + (size_t)(t + 2) * kstep; const char* b2 = last ? nB : cB + (size_t)(t + 2) * kstep;
            const char* a3 = a2 + kstep; const char* b3 = b2 + kstep;
            if (last && has_next) S.a_ready(nxt);
            if constexpr (SP2) {
            PG8_LDB(B0, 0, 0); PG8_LDB(B1, 0, 1); PG8_SCHED; PG8_LDA(At, 0, 0); PG8_STAGE(PG8_SA(1, 1), a1 + hstep, voffA);
            PG8_WAIT_V(8); PG8_WAIT_L(0); PG8_BAR; PG8_MMA(0, 0, At, B0); PG8_MMA(0, 1, At, B1); PG8_BAR; PG8_SCHED;
            PG8_LDA(At, 0, 1); PG8_STAGE(PG8_SB(0, 0), b2, voffB); PG8_STAGE(PG8_SB(0, 1), b2 + hstep, voffB); PG8_STAGE(PG8_SA(0, 0), a2, voffA);
            PG8_WAIT_V(8); PG8_WAIT_L(0); PG8_BAR; PG8_MMA(1, 0, At, B0); PG8_MMA(1, 1, At, B1); PG8_BAR; PG8_SCHED;
            PG8_LDB(B0, 1, 0); PG8_LDB(B1, 1, 1); PG8_SCHED; PG8_LDA(At, 1, 0); PG8_STAGE(PG8_SA(0, 1), a2 + hstep, voffA);
            PG8_WAIT_V(8); PG8_WAIT_L(0); PG8_BAR; PG8_MMA(0, 0, At, B0); PG8_MMA(0, 1, At, B1); PG8_BAR; PG8_SCHED;
            PG8_LDA(At, 1, 1); PG8_STAGE(PG8_SB(1, 0), b3, voffB); PG8_STAGE(PG8_SB(1, 1), b3 + hstep, voffB); PG8_STAGE(PG8_SA(1, 0), a3, voffA);
            PG8_WAIT_V(8); PG8_WAIT_L(0); PG8_BAR; PG8_MMA(1, 0, At, B0); PG8_MMA(1, 1, At, B1); PG8_BAR; PG8_SCHED;
            } else {
            PG8_LDB(B0, 0, 0); PG8_SCHED; PG8_LDA(At, 0, 0); PG8_STAGE(PG8_SA(1, 1), a1 + hstep, voffA);
            PG8_WAIT_L(8); PG8_BAR; PG8_WAIT_L(0); PG8_MMA(0, 0, At, B0); PG8_BAR; PG8_SCHED;
            PG8_LDB(B1, 0, 1); PG8_STAGE(PG8_SB(0, 0), b2, voffB);
            PG8_BAR; PG8_WAIT_L(0); PG8_MMA(0, 1, At, B1); PG8_BAR;
            PG8_LDA(At, 0, 1); PG8_STAGE(PG8_SA(0, 0), a2, voffA);
            PG8_BAR; PG8_WAIT_L(0); PG8_MMA(1, 0, At, B0); PG8_BAR; PG8_SCHED;
            PG8_STAGE(PG8_SB(0, 1), b2 + hstep, voffB);
            PG8_WAIT_V(6); PG8_BAR; PG8_MMA(1, 1, At, B1); PG8_BAR;
            PG8_LDB(B0, 1, 0); PG8_SCHED; PG8_LDA(At, 1, 0); PG8_STAGE(PG8_SA(0, 1), a2 + hstep, voffA);
            PG8_WAIT_L(8); PG8_BAR; PG8_WAIT_L(0); PG8_MMA(0, 0, At, B0); PG8_BAR; PG8_SCHED;
            PG8_LDB(B1, 1, 1); PG8_STAGE(PG8_SB(1, 0), b3, voffB);
            PG8_BAR; PG8_WAIT_L(0); PG8_MMA(0, 1, At, B1); PG8_BAR;
            PG8_LDA(At, 1, 1); PG8_STAGE(PG8_SA(1, 0), a3, voffA);
            PG8_BAR; PG8_WAIT_L(0); PG8_MMA(1, 0, At, B0); PG8_BAR; PG8_SCHED;
            PG8_STAGE(PG8_SB(1, 1), b3 + hstep, voffB);
            PG8_WAIT_V(6); PG8_BAR; PG8_MMA(1, 1, At, B1); PG8_BAR;
            }
        }
        if constexpr (ALIGN_EPI) { if (wr == 0) PG8_BAR; }
        if constexpr (!Epi::AFTER_DRAIN) { MFMA_SETTLE(); E(acc, cur, wr, wc, fr, fq); S.done(cur); }
        if (!has_next) break;
#pragma unroll
        for (int a = 0; a < 2; ++a)
#pragma unroll
            for (int b = 0; b < 2; ++b)
#pragma unroll
                for (int m = 0; m < 4; ++m)
#pragma unroll
                    for (int n = 0; n < 2; ++n) acc[a][b][m][n] = (f32x4){0.f, 0.f, 0.f, 0.f};
        cur = nxt; cA = nA; cB = nB; ++ui;
        if constexpr (ALIGN_EPI) { if (wr == 1) PG8_BAR; }
    }
    PG8_WAIT_V(0);
    if constexpr (!ALIGN_EPI) { if (wr == 0) PG8_BAR; }
    PG8_BAR;
    if constexpr (Epi::AFTER_DRAIN) { E.fused(acc, cur, wr, wc, fr, fq, lds, wid, lane); S.done(cur); }
#undef PG8_SA
#undef PG8_SB
#undef PG8_STAGE
#undef PG8_LDA
#undef PG8_LDB
#undef PG8_MMA
#undef PG8_WAIT_V
#undef PG8_WAIT_L
#undef PG8_BAR
#undef PG8_SCHED
}
}
using pg8::MP; using pg8::MPROMPT; using pg8::MTOT;
constexpr int NWAVES = 8, NTHR = 512;
constexpr int DM = 2048, NIN = 11264, DFF = 8192, NSAMP = 128;
constexpr float EPS = 1e-6f;
constexpr size_t MiB = 1u << 20;
constexpr size_t SZ1 = (size_t)MP * 1024 * 2;
constexpr size_t WS_SS = 0, WS_SS2 = 36864, WS_DEC = 256 * 1024;
constexpr size_t WS_WIN = 1 * MiB, WS_WAB = 45 * MiB, WS_WOUT = 53 * MiB, WS_WUP = 61 * MiB, WS_WDN = 93 * MiB;
constexpr size_t WS_XN = 125 * MiB;
constexpr size_t WS_U = 158 * MiB, WS_BG = WS_U + SZ1, WS_LOGF = WS_U + 2 * SZ1, WS_Q = WS_U + 4 * SZ1, WS_IV = WS_U + 5 * SZ1, WS_OG = WS_U + 6 * SZ1, WS_KIN = WS_U + 7 * SZ1;
constexpr size_t WS_R = WS_U + 8 * SZ1, WS_GBS = WS_U + 10 * SZ1, WS_QIN = WS_U + 12 * SZ1, WS_END = WS_U + 13 * SZ1;
constexpr size_t WS_X1B = WS_WIN;
constexpr size_t WS_ST = WS_WIN;
constexpr size_t WS_MIX = WS_U;
constexpr size_t WS_A3 = WS_LOGF;
constexpr size_t WS_H = WS_Q;
static_assert(WS_END <= 378 * MiB, "ws map");
constexpr size_t O_YP = 0, O_YS = 16777216, O_NCP = 17039360, O_NHP = 17047552, O_NCS = 17571840, O_NHS = 17833984;
constexpr int LDS_BYTES = 139264;

#define GAS __attribute__((address_space(1)))
#define LAS __attribute__((address_space(3)))
typedef unsigned short bf16;
typedef unsigned v4u __attribute__((ext_vector_type(4)));
typedef unsigned v2u __attribute__((ext_vector_type(2)));
typedef float f32x4 __attribute__((ext_vector_type(4)));
typedef short bf16x8 __attribute__((ext_vector_type(8)));
#define LDS_WAIT() asm volatile("s_waitcnt lgkmcnt(0)" ::: "memory")
__device__ __forceinline__ unsigned f2bf(float f) { unsigned u = __builtin_bit_cast(unsigned, f); return (u + 0x7fffu + ((u >> 16) & 1u)) >> 16; }
__device__ __forceinline__ unsigned pk2(float lo, float hi) { return f2bf(lo) | (f2bf(hi) << 16); }
__device__ __forceinline__ float bf2f(unsigned short h) { return __uint_as_float(((unsigned)h) << 16); }
__device__ __forceinline__ float wave_sum(float v) {
#pragma unroll
    for (int o = 1; o < 64; o <<= 1) v += __shfl_xor(v, o);
    return v;
}

#define RLX_AGENT __ATOMIC_RELAXED, __HIP_MEMORY_SCOPE_AGENT
constexpr size_t WS_BAR = 128 * 1024, WS_PCNT = WS_BAR + 16384, WS_CTL_BYTES = 32768;
#define XB_TMO      128
#define XB_XCNT(j)  (256  + 64 * (j))
#define XB_XSUB(j)  (1280 + 64 * (j))
#define XB_XGEN(j)  (2304 + 64 * (j))
#define XB_TOP      3328
#define XB_TOPGEN   3392
#define XCD_BAR_WORDS 3456
#define XB_SPIN_CAP (1u << 18)

__device__ __forceinline__ unsigned xb_ld(unsigned* p)              { return __hip_atomic_load(p, __ATOMIC_RELAXED, __HIP_MEMORY_SCOPE_AGENT); }
__device__ __forceinline__ unsigned xb_add(unsigned* p, unsigned v) { return __hip_atomic_fetch_add(p, v, __ATOMIC_RELAXED, __HIP_MEMORY_SCOPE_AGENT); }
__device__ __forceinline__ unsigned xb_xcc_id() { return (unsigned)__builtin_amdgcn_s_getreg((3 << 11) | 20) & 0xFu; }
#define XB_SPIN(cond, bar) do { unsigned _sp = 0; while (cond) { __builtin_amdgcn_s_sleep(1); \
    if ((++_sp & 255u) == 0u) { if (xb_ld(&(bar)[XB_TMO])) break; if (_sp > XB_SPIN_CAP) { atomicAdd(&(bar)[XB_TMO], 1u); break; } } } } while (0)

struct XcdBarrier {
    unsigned* bar; unsigned x;
    volatile LAS unsigned* st;
};

__device__ __forceinline__ XcdBarrier xcd_barrier_post(unsigned* bar, volatile LAS unsigned* st) {
    XcdBarrier b; b.bar = bar; b.x = xb_xcc_id(); b.st = st;
    if (threadIdx.x == 0) (void)xb_add(&bar[XB_XCNT(b.x)], 1u);
    return b;
}
__device__ __forceinline__ void xcd_barrier_complete(unsigned* bar, unsigned x, unsigned& nloc, unsigned& nx) {
    const unsigned G = gridDim.x * gridDim.y * gridDim.z;
    unsigned sum, cnt, mine, sp = 0u;
    for (;;) {
        sum = 0u; cnt = 0u; mine = 0u;
#pragma unroll
        for (unsigned j = 0; j < 16; ++j) { const unsigned c = xb_ld(&bar[XB_XCNT(j)]); sum += c; cnt += (c > 0u) ? 1u : 0u; mine = (j == x) ? c : mine; }
        if (sum == G) break;
        __builtin_amdgcn_s_sleep(1);
        if ((++sp & 255u) == 0u) { if (xb_ld(&bar[XB_TMO])) break; if (sp > XB_SPIN_CAP) { atomicAdd(&bar[XB_TMO], 1u); break; } }
    }
    nloc = mine > 0u ? mine : 1u; nx = cnt > 0u ? cnt : 1u;
}

__device__ __forceinline__ void xcd_barrier(const XcdBarrier& b) {
    asm volatile("s_waitcnt vmcnt(0)" ::: "memory");
    __syncthreads();
    if (threadIdx.x == 0) {
        unsigned* bar = b.bar;
        __builtin_amdgcn_s_waitcnt(0);
        unsigned nloc = b.st[0], nx = b.st[1];
        if (nloc == 0u) { xcd_barrier_complete(bar, b.x, nloc, nx); b.st[0] = nloc; b.st[1] = nx; }
        const unsigned old = xb_add(&bar[XB_XSUB(b.x)], 1u);
        const unsigned gen = old / nloc;
        if (old + 1u == (gen + 1u) * nloc) {
            __builtin_amdgcn_fence(__ATOMIC_RELEASE, "agent");
            asm volatile("s_waitcnt vmcnt(0)" ::: "memory");
            const unsigned og = xb_add(&bar[XB_TOP], 1u);
            const unsigned tg = og / nx;
            if (og + 1u == (tg + 1u) * nx) xb_add(&bar[XB_TOPGEN], 1u);
            else XB_SPIN(xb_ld(&bar[XB_TOPGEN]) == tg, bar);
            __builtin_amdgcn_fence(__ATOMIC_ACQUIRE, "agent");
            xb_add(&bar[XB_XGEN(b.x)], 1u);
            asm volatile("s_waitcnt vmcnt(0)" ::: "memory");
        } else {
            XB_SPIN(xb_ld(&bar[XB_XGEN(b.x)]) == gen, bar);
            __builtin_amdgcn_fence(__ATOMIC_ACQUIRE, "agent");
            asm volatile("s_waitcnt vmcnt(0)" ::: "memory");
        }
    }
    __syncthreads();
}

#ifndef WGM_G1
#define WGM_G1 8
#endif
#ifndef WGM_UP
#define WGM_UP 4
#endif
#ifndef WGM_N2K
#define WGM_N2K 4
#endif
struct Ctx { LAS unsigned char* lds; int tid, lane, wave, G, bid; };

__device__ __forceinline__ void p0_transpose_item(const float* W, int Nsrc, int k0, int n_src0, bf16* WT, int KT, int n_dst0, int k_dst0, LAS float* scr, int lane, const float* ks = nullptr) {
#pragma unroll 8
    for (int i = 0; i < 32; ++i) { const int kk = 2 * i + (lane >> 5); scr[kk * 33 + (lane & 31)] = __builtin_nontemporal_load(W + (size_t)(k0 + kk) * Nsrc + n_src0 + (lane & 31)); }
    LDS_WAIT(); asm volatile("" ::: "memory");
    const int c = lane & 7;
    f32x4 ka = (f32x4){1.f, 1.f, 1.f, 1.f}, kb = ka;
    if (ks) { ka = *(const f32x4*)(ks + k0 + 8 * c); kb = *(const f32x4*)(ks + k0 + 8 * c + 4); }
#pragma unroll
    for (int j = 0; j < 4; ++j) { const int n = (lane >> 3) + 8 * j; const LAS float* s = scr + (8 * c) * 33 + n;
        v4u o; o.x = pk2(s[0 * 33] * ka.x, s[1 * 33] * ka.y); o.y = pk2(s[2 * 33] * ka.z, s[3 * 33] * ka.w); o.z = pk2(s[4 * 33] * kb.x, s[5 * 33] * kb.y); o.w = pk2(s[6 * 33] * kb.z, s[7 * 33] * kb.w);
        *(GAS v4u*)(WT + (size_t)(n_dst0 + n) * KT + k_dst0 + 8 * c) = o; }
    LDS_WAIT(); asm volatile("" ::: "memory");
}
__device__ __forceinline__ int g1_src_col(int n) {
    const int tile = n >> 8, within = n & 255, half = within >> 7, i = within & 127;
    if (tile < 8) return (half ? 2048 : 0) + 128 * tile + i;
    if (tile < 28) { const int ty = (tile - 8) >> 2; const int base = ty == 0 ? 1024 : (ty == 1 ? 3072 : (ty == 2 ? 4096 : (ty == 3 ? 5120 : 6144))); return base + ((tile - 8) & 3) * 256 + within; }
    return (half ? 9216 : 7168) + 128 * (tile - 28) + i;
}
__device__ __forceinline__ void rms_row_to_bf16(const float* xrow, const float* g, bf16* orow, int lane) {
    const GAS f32x4* xr = (const GAS f32x4*)xrow + lane; const GAS f32x4* gr = (const GAS f32x4*)g + lane;
    f32x4 v[8]; float s = 0.f;
#pragma unroll
    for (int j = 0; j < 8; ++j) { v[j] = xr[64 * j]; s += (v[j].x * v[j].x + v[j].y * v[j].y) + (v[j].z * v[j].z + v[j].w * v[j].w); }
    const float rstd = __builtin_amdgcn_rsqf(wave_sum(s) * (1.f / DM) + EPS);
    GAS v2u* o8 = (GAS v2u*)orow + lane;
#pragma unroll
    for (int j = 0; j < 8; ++j) { const f32x4 gg = gr[64 * j]; v2u o; o.x = pk2(v[j].x * rstd * gg.x, v[j].y * rstd * gg.y); o.y = pk2(v[j].z * rstd * gg.z, v[j].w * rstd * gg.w); o8[64 * j] = o; }
}
struct P0Args { const float *xp, *xs, *nmix, *win, *wa, *wb, *wout, *wup, *wdn, *nffn; bf16 *WIN, *WAB, *WOUT, *WUP, *WDN, *XN; float* ss; };
__device__ __forceinline__ void p0_prologue(const Ctx& C, const P0Args& a) {
    LAS float* scr = (LAS float*)(C.lds + C.wave * 16384);
    const int gw = C.bid * NWAVES + C.wave, NGW = C.G * NWAVES;
    constexpr int I_IN = 32 * 352, I_A = 16 * 64, I_O = 32 * 64, I_UP = 32 * 256, I_DN = 128 * 64;
    constexpr int NITEMS = I_IN + 2 * I_A + I_O + I_UP + I_DN;
    for (int it = gw; it < NITEMS; it += NGW) {
        int r = it;
        if (r < I_IN) { const int kb = r / 352, nb = r % 352; p0_transpose_item(a.win, NIN, 64 * kb, g1_src_col(32 * nb), a.WIN, 2048, 32 * nb, 64 * kb, scr, C.lane); continue; } r -= I_IN;
        if (r < I_A) { const int kb = r / 64, nb = r % 64; p0_transpose_item(a.wa, 2048, 64 * kb, 32 * nb, a.WAB, 2048, 32 * nb, 64 * kb, scr, C.lane); continue; } r -= I_A;
        if (r < I_A) { const int kb = r / 64, nb = r % 64; p0_transpose_item(a.wb, 2048, 64 * kb, 32 * nb, a.WAB, 2048, 32 * nb, 1024 + 64 * kb, scr, C.lane); continue; } r -= I_A;
        if (r < I_O) { const int kb = r / 64, nb = r % 64; p0_transpose_item(a.wout, 2048, 64 * kb, 32 * nb, a.WOUT, 2048, 32 * nb, 64 * kb, scr, C.lane); continue; } r -= I_O;
        if (r < I_UP) { const int kb = r / 256, nb = r % 256; p0_transpose_item(a.wup, 8192, 64 * kb, 32 * nb, a.WUP, 2048, 32 * nb, 64 * kb, scr, C.lane, a.nffn  ); continue; } r -= I_UP;
        { const int kb = r / 64, nb = r % 64; p0_transpose_item(a.wdn, 2048, 64 * kb, 32 * nb, a.WDN, 8192, 32 * nb, 64 * kb, scr, C.lane); }
    }
    for (int m = gw; m < MP; m += NGW) {
        if (m < MPROMPT) rms_row_to_bf16(a.xp + (size_t)m * DM, a.nmix, a.XN + (size_t)m * DM, C.lane);
        else if (m < MTOT) rms_row_to_bf16(a.xs + (size_t)(m - MPROMPT) * DM, a.nmix, a.XN + (size_t)m * DM, C.lane);
        else { GAS v4u* o = (GAS v4u*)(a.XN + (size_t)m * DM) + C.lane;
#pragma unroll
            for (int j = 0; j < 4; ++j) o[64 * j] = (v4u){0u, 0u, 0u, 0u}; }
    }
    for (int i = C.bid * NTHR + C.tid; i < MP; i += C.G * NTHR) a.ss[i] = 0.f;
    for (int i = C.bid * NTHR + C.tid; i < MPROMPT; i += C.G * NTHR) a.ss[WS_SS2 / 4 + i] = 0.f;
}
struct P2Args { bf16 *U, *BG, *Q, *IV, *OG, *KIN, *A2, *ST, *QIN; float *LOGF, *DEC, *DT; const float *sconv, *shgrn, *convw, *onorm; float *ncs, *nhp, *nhs; };
#define MFMA16(a, b, c) __builtin_amdgcn_mfma_f32_16x16x32_bf16((a), (b), (c), 0, 0, 0)
__device__ __forceinline__ void p2a_chunk(const Ctx& C, const P2Args& a, int item) {
    const int h = item & 7, n = (item >> 3) & 31, b = item >> 8, r0 = b * 2048 + n * 64, c0 = h * 128;
    LAS float* segtot = (LAS float*)C.lds;
    LAS unsigned short* KE = (LAS unsigned short*)(C.lds + 2048);
    LAS unsigned short* VT = KE + 128 * 72;
    const int tid = C.tid, seg = tid >> 7, d = tid & 127;
    float lf[16], cs[16], qv[16]; float run = 0.f;
#pragma unroll
    for (int j = 0; j < 16; ++j) lf[j] = a.LOGF[(size_t)(r0 + seg * 16 + j) * 1024 + c0 + d];
#pragma unroll
    for (int j = 0; j < 16; ++j) qv[j] = bf2f(a.Q[(size_t)(r0 + seg * 16 + j) * 1024 + c0 + d]);
#pragma unroll
    for (int j = 0; j < 16; ++j) { run += lf[j]; cs[j] = run; }
    segtot[seg * 128 + d] = run;
    { const int t = tid >> 3;
#pragma unroll
      for (int cc = 0; cc < 2; ++cc) { const int ch = (tid & 7) * 2 + cc; const v4u w = *(const v4u*)(a.IV + (size_t)(r0 + t) * 1024 + c0 + ch * 8);
          LAS unsigned short* p = VT + (ch * 8) * 72 + t;
          p[0 * 72] = (unsigned short)(w.x & 0xffff); p[1 * 72] = (unsigned short)(w.x >> 16); p[2 * 72] = (unsigned short)(w.y & 0xffff); p[3 * 72] = (unsigned short)(w.y >> 16);
          p[4 * 72] = (unsigned short)(w.z & 0xffff); p[5 * 72] = (unsigned short)(w.z >> 16); p[6 * 72] = (unsigned short)(w.w & 0xffff); p[7 * 72] = (unsigned short)(w.w >> 16); } }
    __syncthreads();
    float pre = 0.f, tot = 0.f;
#pragma unroll
    for (int s = 0; s < 4; ++s) { const float v = segtot[s * 128 + d]; tot += v; if (s < seg) pre += v; }
#pragma unroll
    for (int j = 0; j < 16; ++j) {
        const int t = seg * 16 + j; const size_t gi = (size_t)(r0 + t) * 1024 + c0 + d;
        const float bb = pre + cs[j], k = 1.0f - __expf(lf[j]), q = qv[j];
        a.QIN[gi] = (bf16)f2bf(q * __expf(bb)); a.KIN[gi] = (bf16)f2bf(k * __expf(-bb));
        KE[d * 72 + t] = (unsigned short)f2bf(k * __expf(tot - bb));
    }
    if (seg == 0) a.DEC[(size_t)item * 128 + d] = __expf(tot);
    __syncthreads();
    const int w = C.wave, fr = C.lane & 15, fq = C.lane >> 4;
    const bf16x8 a0 = *(const LAS bf16x8*)(VT + (w * 16 + fr) * 72 + fq * 8), a1 = *(const LAS bf16x8*)(VT + (w * 16 + fr) * 72 + 32 + fq * 8);
    float* dt = a.DT + (size_t)item * 16384;
#pragma unroll
    for (int db = 0; db < 8; ++db) {
        const bf16x8 b0 = *(const LAS bf16x8*)(KE + (db * 16 + fr) * 72 + fq * 8), b1 = *(const LAS bf16x8*)(KE + (db * 16 + fr) * 72 + 32 + fq * 8);
        f32x4 acc = (f32x4){0.f, 0.f, 0.f, 0.f};
        acc = MFMA16(a0, b0, acc); acc = MFMA16(a1, b1, acc);
#pragma unroll
        for (int i = 0; i < 4; ++i) dt[(w * 16 + 4 * fq + i) * 128 + db * 16 + fr] = acc[i];
    }
    __syncthreads();
}
__device__ __forceinline__ void p2a_sample(const Ctx& C, const P2Args& a, int it) {
    const int h = it & 7, i = it >> 3, c0 = h * 128; const size_t row = MPROMPT + i;
    LAS float* red = (LAS float*)C.lds;
    LAS float* wsum = red + 16 * 128;
    const int tid = C.tid, e = (tid & 31) * 4, dg = tid >> 5;
    const float* S0 = a.shgrn + (size_t)(i * 8 + h) * 16384; float* SN = a.nhs + (size_t)(i * 8 + h) * 16384;
    const v2u vw = *(const v2u*)(a.IV + row * 1024 + c0 + e);
    const f32x4 v4 = (f32x4){pg8::bf_lo(vw.x), pg8::bf_hi(vw.x), pg8::bf_lo(vw.y), pg8::bf_hi(vw.y)};
    f32x4 o = (f32x4){0.f, 0.f, 0.f, 0.f};
    f32x4 sv[8]; float fv[8], qv[8];
#pragma unroll
    for (int j = 0; j < 8; ++j) { const int d = dg * 8 + j; sv[j] = __builtin_nontemporal_load((const f32x4*)(S0 + d * 128 + e)); fv[j] = a.LOGF[row * 1024 + c0 + d]; qv[j] = bf2f(a.Q[row * 1024 + c0 + d]); }
#pragma unroll
    for (int j = 0; j < 8; ++j) {
        const int d = dg * 8 + j; const float f = __expf(fv[j]), k = 1.0f - f, q = qv[j];
        const f32x4 s = sv[j]; const f32x4 sn = s * f + v4 * k;
        __builtin_nontemporal_store(sn, (f32x4*)(SN + d * 128 + e)); o += sn * q;
    }
    *(LAS f32x4*)(red + dg * 128 + e) = o;
    __syncthreads();
    float oo = 0.f;
    if (tid < 128) {
#pragma unroll
        for (int g = 0; g < 16; ++g) oo += red[g * 128 + tid];
        const float ss = wave_sum(oo * oo); if (C.lane == 0) wsum[C.wave] = ss;
    }
    __syncthreads();
    if (tid < 128) {
        const float rstd = __builtin_amdgcn_rsqf((wsum[0] + wsum[1]) * (1.f / 128.f) + EPS);
        a.A2[row * 2048 + 1024 + c0 + tid] = (bf16)f2bf(oo * rstd * a.onorm[tid] * bf2f(a.OG[row * 1024 + c0 + tid]));
    }
    __syncthreads();
}
__device__ __forceinline__ void p2a_conv(const Ctx& C, const P2Args& a, int it) {
    const int row = it * 4 + (C.tid >> 7), c8 = (C.tid & 127) * 8;
    if (row >= MTOT) return;
    f32x4 u0a, u0b, u1a, u1b, u2a, u2b, ba, bb; const f32x4 z = (f32x4){0.f, 0.f, 0.f, 0.f};
    pg8::unpack8(*(const v4u*)(a.U + (size_t)row * 1024 + c8), u0a, u0b);
    pg8::unpack8(*(const v4u*)(a.BG + (size_t)row * 1024 + c8), ba, bb);
    if (row < MPROMPT) {
        const int t = row & 2047;
        if (t >= 1) pg8::unpack8(*(const v4u*)(a.U + (size_t)(row - 1) * 1024 + c8), u1a, u1b); else { u1a = z; u1b = z; }
        if (t >= 2) pg8::unpack8(*(const v4u*)(a.U + (size_t)(row - 2) * 1024 + c8), u2a, u2b); else { u2a = z; u2b = z; }
    } else {
        const int i = row - MPROMPT; const float* sc = a.sconv + (size_t)i * 2048 + c8;
        u2a = *(const f32x4*)sc; u2b = *(const f32x4*)(sc + 4); u1a = *(const f32x4*)(sc + 1024); u1b = *(const f32x4*)(sc + 1028);
        float* nc = a.ncs + (size_t)i * 2048 + c8; *(f32x4*)nc = u1a; *(f32x4*)(nc + 4) = u1b;
    }
    const float* cw = a.convw + c8;
    const f32x4 w0a = *(const f32x4*)cw, w0b = *(const f32x4*)(cw + 4), w1a = *(const f32x4*)(cw + 1024), w1b = *(const f32x4*)(cw + 1028), w2a = *(const f32x4*)(cw + 2048), w2b = *(const f32x4*)(cw + 2052);
    const f32x4 ra = ba * (w0a * u2a + w1a * u1a + w2a * u0a), rb = bb * (w0b * u2b + w1b * u1b + w2b * u0b);
    *(v4u*)(a.A2 + (size_t)row * 2048 + c8) = pg8::pack8(ra, rb);
}
__device__ __forceinline__ void p2a_phase(const Ctx& C, const P2Args& a) {
    constexpr int N_CH = 1024, N_SA = 1024, N_CV = (MTOT + 3) / 4;
    for (int it = C.bid; it < N_SA + N_CH + N_CV; it += C.G) {
        if (it < N_SA) p2a_sample(C, a, it);
        else if (it < N_SA + N_CH) p2a_chunk(C, a, it - N_SA);
        else p2a_conv(C, a, it - N_SA - N_CH);
    }
}
__device__ __forceinline__ void p2b_phase(const Ctx& C, const P2Args& a) {
    for (int gid = C.bid * NTHR + C.tid; gid < 131072; gid += C.G * NTHR) {
        const int d = (gid & 31) * 4, e = (gid >> 5) & 127, bh = gid >> 12, b = bh >> 3, h = bh & 7;
        f32x4 S = (f32x4){0.f, 0.f, 0.f, 0.f};
        for (int n0 = 0; n0 < 32; n0 += 8) {
            f32x4 dl[8], dc[8];
#pragma unroll
            for (int q = 0; q < 8; ++q) { const size_t item = (size_t)((b * 32 + n0 + q) * 8 + h); dl[q] = *(const f32x4*)(a.DT + (item * 128 + e) * 128 + d); dc[q] = *(const f32x4*)(a.DEC + item * 128 + d); }
#pragma unroll
            for (int q = 0; q < 8; ++q) {
                const size_t item = (size_t)((b * 32 + n0 + q) * 8 + h);
                v2u w; w.x = pk2(S[0], S[1]); w.y = pk2(S[2], S[3]);
                *(v2u*)(a.ST + (item * 128 + e) * 128 + d) = w;
                S = dc[q] * S + dl[q];
            }
        }
        float* o = a.nhp + ((size_t)bh * 128 + d) * 128 + e;
        o[0] = S[0]; o[128] = S[1]; o[256] = S[2]; o[384] = S[3];
    }
}
__device__ __forceinline__ void p2c_chunk(const Ctx& C, const P2Args& a, int item) {
    const int h = item & 7, n = (item >> 3) & 31, b = item >> 8, r0 = b * 2048 + n * 64, c0 = h * 128;
    LAS unsigned short* QS = (LAS unsigned short*)C.lds;
    LAS unsigned short* KS = QS + 64 * 136;
    LAS unsigned short* VT = KS + 64 * 136;
    LAS unsigned short* PS = VT + 128 * 72;
    LAS float* OS = (LAS float*)(PS + 64 * 72);
    LAS unsigned short* STS = (LAS unsigned short*)(OS + 64 * 132);
    const int tid = C.tid;
#pragma unroll
    for (int cc = 0; cc < 2; ++cc) {
        const int id = tid + cc * 512, t = id >> 4, ch = id & 15; const size_t gi = (size_t)(r0 + t) * 1024 + c0 + ch * 8;
        *(LAS v4u*)(QS + t * 136 + ch * 8) = *(const v4u*)(a.QIN + gi);
        *(LAS v4u*)(KS + t * 136 + ch * 8) = *(const v4u*)(a.KIN + gi);
        const v4u w = *(const v4u*)(a.IV + gi);
        LAS unsigned short* p = VT + (ch * 8) * 72 + t;
        p[0 * 72] = (unsigned short)(w.x & 0xffff); p[1 * 72] = (unsigned short)(w.x >> 16); p[2 * 72] = (unsigned short)(w.y & 0xffff); p[3 * 72] = (unsigned short)(w.y >> 16);
        p[4 * 72] = (unsigned short)(w.z & 0xffff); p[5 * 72] = (unsigned short)(w.z >> 16); p[6 * 72] = (unsigned short)(w.w & 0xffff); p[7 * 72] = (unsigned short)(w.w >> 16);
    }
    {
        const bf16* stg = a.ST + (size_t)item * 16384;
#pragma unroll
        for (int cc = 0; cc < 4; ++cc) { const int id = tid + cc * 512, e = id >> 4, ch = id & 15; *(LAS v4u*)(STS + e * 136 + ch * 8) = *(const v4u*)(stg + e * 128 + ch * 8); }
    }
    __syncthreads();
    const int w = C.wave, fr = C.lane & 15, fq = C.lane >> 4, lb = w >> 1;
    bf16x8 qa[4];
#pragma unroll
    for (int kk = 0; kk < 4; ++kk) qa[kk] = *(const LAS bf16x8*)(QS + (lb * 16 + fr) * 136 + kk * 32 + fq * 8);
#pragma unroll
    for (int sj = 0; sj < 2; ++sj) {
        const int sb = (w & 1) * 2 + sj; f32x4 acc = (f32x4){0.f, 0.f, 0.f, 0.f};
#pragma unroll
        for (int kk = 0; kk < 4; ++kk) acc = MFMA16(qa[kk], *(const LAS bf16x8*)(KS + (sb * 16 + fr) * 136 + kk * 32 + fq * 8), acc);
#pragma unroll
        for (int i = 0; i < 4; ++i) { const int l = lb * 16 + 4 * fq + i, s = sb * 16 + fr; PS[l * 72 + s] = (unsigned short)f2bf(s <= l ? acc[i] : 0.f); }
    }
    __syncthreads();
    const bf16x8 p0 = *(const LAS bf16x8*)(PS + (lb * 16 + fr) * 72 + fq * 8), p1 = *(const LAS bf16x8*)(PS + (lb * 16 + fr) * 72 + 32 + fq * 8);
#pragma unroll
    for (int ej = 0; ej < 4; ++ej) {
        const int eb = (w & 1) * 4 + ej; f32x4 acc = (f32x4){0.f, 0.f, 0.f, 0.f};
        acc = MFMA16(p0, *(const LAS bf16x8*)(VT + (eb * 16 + fr) * 72 + fq * 8), acc);
        acc = MFMA16(p1, *(const LAS bf16x8*)(VT + (eb * 16 + fr) * 72 + 32 + fq * 8), acc);
#ifndef DBG_NO_ST
#pragma unroll
        for (int kk = 0; kk < 4; ++kk) acc = MFMA16(qa[kk], *(const LAS bf16x8*)(STS + (eb * 16 + fr) * 136 + kk * 32 + fq * 8), acc);
#endif
#pragma unroll
        for (int i = 0; i < 4; ++i) OS[(lb * 16 + 4 * fq + i) * 132 + eb * 16 + fr] = acc[i];
    }
    __syncthreads();
    {
        const int l = tid >> 3, part = tid & 7; float v[16]; float ss = 0.f;
#pragma unroll
        for (int j = 0; j < 16; ++j) { v[j] = OS[l * 132 + part * 16 + j]; ss += v[j] * v[j]; }
        ss += __shfl_xor(ss, 1); ss += __shfl_xor(ss, 2); ss += __shfl_xor(ss, 4);
        const float rstd = __builtin_amdgcn_rsqf(ss * (1.f / 128.f) + EPS);
        const size_t row = (size_t)(r0 + l);
#pragma unroll
        for (int hh = 0; hh < 2; ++hh) {
            f32x4 ga, gb; pg8::unpack8(*(const v4u*)(a.OG + row * 1024 + c0 + part * 16 + hh * 8), ga, gb);
            const f32x4 na = *(const f32x4*)(a.onorm + part * 16 + hh * 8), nb = *(const f32x4*)(a.onorm + part * 16 + hh * 8 + 4);
            f32x4 ra, rb;
#pragma unroll
            for (int i = 0; i < 4; ++i) { ra[i] = v[hh * 8 + i] * rstd * na[i] * ga[i]; rb[i] = v[hh * 8 + 4 + i] * rstd * nb[i] * gb[i]; }
            *(v4u*)(a.A2 + row * 2048 + 1024 + c0 + part * 16 + hh * 8) = pg8::pack8(ra, rb);
        }
    }
    __syncthreads();
}
template <int RB, class Epi>
__device__ __forceinline__ void skinny_phase(const Ctx& C, const bf16* A, const bf16* Bt, int N, int K, const Epi& E) {
    const int ncb = N / 64, nrb = NSAMP / (16 * RB), nunits = ncb * nrb;
    const int w = C.wave, l = C.lane, fr = l & 15, fq = l >> 4, ks = K / 8;
    LAS float* red = (LAS float*)C.lds;
    for (int u = C.bid; u < nunits; u += C.G) {
        const int cb = u % ncb, rb = u / ncb;
        f32x4 acc[RB][4];
#pragma unroll
        for (int r = 0; r < RB; ++r)
#pragma unroll
            for (int c = 0; c < 4; ++c) acc[r][c] = (f32x4){0.f, 0.f, 0.f, 0.f};
        const bf16* ap = A + (size_t)(rb * 16 * RB + fr) * K + w * ks + fq * 8;
        const bf16* bp = Bt + (size_t)(cb * 64 + fr) * K + w * ks + fq * 8;
#pragma unroll 4
        for (int k = 0; k < ks; k += 32) {
            bf16x8 af[RB], bfr[4];
#pragma unroll
            for (int r = 0; r < RB; ++r) af[r] = *(const bf16x8*)(ap + (size_t)r * 16 * K + k);
#pragma unroll
            for (int c = 0; c < 4; ++c) bfr[c] = *(const bf16x8*)(bp + (size_t)c * 16 * K + k);
#pragma unroll
            for (int r = 0; r < RB; ++r)
#pragma unroll
                for (int c = 0; c < 4; ++c) acc[r][c] = MFMA16(bfr[c], af[r], acc[r][c]);
        }
        MFMA_SETTLE();
#pragma unroll
        for (int r = 0; r < RB; ++r)
#pragma unroll
            for (int c = 0; c < 4; ++c) *(LAS f32x4*)(red + ((w * RB * 4 + r * 4 + c) * 64 + l) * 4) = acc[r][c];
        __syncthreads();
        for (int s = C.tid; s < RB * 256; s += NTHR) {
            const int r = s >> 8, c = (s >> 6) & 3, ln = s & 63;
            f32x4 lo = (f32x4){0.f, 0.f, 0.f, 0.f}, hi = lo;
#pragma unroll
            for (int ww = 0; ww < 4; ++ww) { lo += *(const LAS f32x4*)(red + ((ww * RB * 4 + r * 4 + c) * 64 + ln) * 4); hi += *(const LAS f32x4*)(red + (((ww + 4) * RB * 4 + r * 4 + c) * 64 + ln) * 4); }
            E(rb * 16 * RB + r * 16 + (ln & 15), cb * 64 + c * 16 + 4 * (ln >> 4), lo, hi);
        }
        __syncthreads();
    }
}
__device__ __forceinline__ f32x4 ld4bf(const bf16* p) { const v2u w = *(const v2u*)p; return (f32x4){pg8::bf_lo(w.x), pg8::bf_hi(w.x), pg8::bf_lo(w.y), pg8::bf_hi(w.y)}; }
__device__ __forceinline__ void st4bf(bf16* p, const f32x4 v) { v2u w; w.x = pg8::cvt_pk_bf16(v[0], v[1]); w.y = pg8::cvt_pk_bf16(v[2], v[3]); *(v2u*)p = w; }
struct SkG2 { const bf16 *R, *GBS; bf16* MIX;
    __device__ __forceinline__ void operator()(int row, int col, f32x4 lo, f32x4 hi) const { const size_t o = (size_t)row * 2048 + col; st4bf(MIX + o, (lo * ld4bf(R + o) + hi) * ld4bf(GBS + o)); } };
struct SkG3 { const float* X; float* X1; bf16* A3; const float* g; float* ss;
    __device__ __forceinline__ void operator()(int row, int col, f32x4 lo, f32x4 hi) const { const size_t o = (size_t)row * 2048 + col;
        const f32x4 x1 = *(const f32x4*)(X + o) + lo + hi; *(f32x4*)(X1 + o) = x1; st4bf(A3 + o, x1);
        float s = (x1[0] * x1[0] + x1[1] * x1[1]) + (x1[2] * x1[2] + x1[3] * x1[3]); s += __shfl_xor(s, 16); s += __shfl_xor(s, 32);
        if ((threadIdx.x & 63) < 16) atomicAdd(ss + row, s); } };
struct SkUp { bf16* H; const float* ss;
    __device__ __forceinline__ void operator()(int row, int col, f32x4 lo, f32x4 hi) const { const float rs = __builtin_amdgcn_rsqf(ss[row] * (1.0f / 2048.0f) + EPS);
        f32x4 v = (lo + hi) * rs;
#pragma unroll
        for (int i = 0; i < 4; ++i) { const float t = fmaxf(v[i], 0.f); v[i] = t * t; }
        st4bf(H + (size_t)row * 8192 + col, v); } };
struct SkDown { float* X1;
    __device__ __forceinline__ void operator()(int row, int col, f32x4 lo, f32x4 hi) const { float* p = X1 + (size_t)row * 2048 + col; *(f32x4*)p = *(const f32x4*)p + lo + hi; } };

struct Args { const float* in[16]; float* out; unsigned char* ws; int ph_lo, ph_hi; };
constexpr int NPHASE = 10;
__global__ void __launch_bounds__(NTHR, 2) mk_fwd(Args args) {
    extern __shared__ __attribute__((aligned(16))) unsigned char lds_raw[];
    cg::grid_group grid = cg::this_grid();
    Ctx C; C.lds = (LAS unsigned char*)lds_raw; C.tid = threadIdx.x; C.lane = C.tid & 63; C.wave = __builtin_amdgcn_readfirstlane(C.tid >> 6); C.G = gridDim.x; C.bid = blockIdx.x;
    unsigned char* ws = args.ws; float* out = args.out;
    const float *x_prompt = args.in[0], *x_sample = args.in[1], *state_conv = args.in[2], *state_hgrn = args.in[3], *norm_mix = args.in[4], *w_in = args.in[5], *conv_w = args.in[6],
                *lb_logits = args.in[7], *onorm_g = args.in[8], *w_a = args.in[9], *w_b = args.in[10], *w_out = args.in[11], *norm_ffn = args.in[12], *w_up = args.in[13], *w_down = args.in[14], *norm_final = args.in[15];
    bf16 *WIN = (bf16*)(ws + WS_WIN), *WAB = (bf16*)(ws + WS_WAB), *WOUT = (bf16*)(ws + WS_WOUT), *WUP = (bf16*)(ws + WS_WUP), *WDN = (bf16*)(ws + WS_WDN);
    bf16 *XN = (bf16*)(ws + WS_XN), *U = (bf16*)(ws + WS_U), *BG = (bf16*)(ws + WS_BG), *Q = (bf16*)(ws + WS_Q), *IV = (bf16*)(ws + WS_IV), *OG = (bf16*)(ws + WS_OG), *KIN = (bf16*)(ws + WS_KIN), *QIN = (bf16*)(ws + WS_QIN), *A3 = (bf16*)(ws + WS_A3), *X1B = (bf16*)(ws + WS_X1B);
    bf16 *R = (bf16*)(ws + WS_R), *GBS = (bf16*)(ws + WS_GBS), *ST = (bf16*)(ws + WS_ST), *MIX = (bf16*)(ws + WS_MIX), *H = (bf16*)(ws + WS_H);
    float *LOGF = (float*)(ws + WS_LOGF), *SS = (float*)(ws + WS_SS), *DEC = (float*)(ws + WS_DEC), *DT = out + O_YP, *X1 = out + O_YP;
    { volatile LAS unsigned* misc = (volatile LAS unsigned*)(C.lds + 131072 + 512); if (C.tid < 2) misc[C.tid] = 0u; }
    __syncthreads();
    XcdBarrier xbar = xcd_barrier_post((unsigned*)(ws + WS_BAR), (volatile LAS unsigned*)(C.lds + 131072 + 512));
    if (args.ph_lo > 100) grid.sync();
    const int lo = args.ph_lo, hi = args.ph_hi;
#ifndef PH_MASK
#define PH_MASK 0x3ff
#endif
#define IN(k) (((PH_MASK >> (k)) & 1) && lo <= (k) && (k) < hi)
#ifndef REP_MASK
#define REP_MASK 0
#endif
#ifndef SEAM_REP
#define SEAM_REP 1
#endif
#ifdef DBG_DUMP_AFTER
#define DUMP(k) do { if ((k) == DBG_DUMP_AFTER) { xcd_barrier(xbar); for (size_t i_ = (size_t)C.bid * NTHR + C.tid; i_ < (size_t)MTOT * 2048; i_ += (size_t)C.G * NTHR) out[i_] = bf2f((DBG_DUMP_BUF)[i_]); } } while (0)
#else
#define DUMP(k) do {} while (0)
#endif
#define REPS(k) for (int rep_ = 0; rep_ < (((REP_MASK >> (k)) & 1) ? 2 : 1); ++rep_)
#define SEAM(k) do { if ((k) + 1 < hi) for (int sr_ = 0; sr_ < SEAM_REP; ++sr_) { xcd_barrier(xbar); } } while (0)
    if (IN(0)) { P0Args a{x_prompt, x_sample, norm_mix, w_in, w_a, w_b, w_out, w_up, w_down, norm_ffn, WIN, WAB, WOUT, WUP, WDN, XN, SS}; REPS(0) p0_prologue(C, a); SEAM(0); }
    if (IN(1)) {
        pg8::Gemm g{XN, WIN, MP, NIN, DM}; pg8::StaticOrder S; S.init(MP, NIN, C.G, C.bid, WGM_G1);
        pg8::EpiG1 E{U, BG, Q, IV, OG, R, GBS, LOGF, lb_logits, out + O_NCP, out + O_NCS};
        REPS(1) pg8::gemm_phase<pg8::EpiG1, pg8::StaticOrder, true, true>(C.lds, g, S, E);
        SEAM(1); DUMP(1);
    }
    P2Args p2{U, BG, Q, IV, OG, KIN, XN, ST, QIN, LOGF, DEC, DT, state_conv, state_hgrn, conv_w, onorm_g, out + O_NCS, out + O_NHP, out + O_NHS};
    if (IN(2)) { REPS(2) p2a_phase(C, p2); SEAM(2); DUMP(2); }
    if (IN(3)) { REPS(3) p2b_phase(C, p2); SEAM(3); DUMP(3); }
    if (IN(4)) { REPS(4) for (int it = C.bid; it < 1024; it += C.G) p2c_chunk(C, p2, it); SEAM(4); DUMP(4); }

    if (IN(5)) {
        pg8::Gemm g{XN, WAB, MPROMPT, DM, DM}; pg8::StaticOrder S; S.init(MPROMPT, DM, C.G, C.bid, WGM_N2K);
        pg8::EpiG2 E{R, GBS, MIX};
        REPS(5) pg8::gemm_phase<pg8::EpiG2, pg8::StaticOrder, true, true>(C.lds, g, S, E);
        const size_t ro = (size_t)MPROMPT * 2048;
        SkG2 e{R + ro, GBS + ro, MIX + ro}; REPS(10) skinny_phase<1, SkG2>(C, XN + ro, WAB, DM, DM, e);
        SEAM(5); DUMP(5);
    }
    if (IN(6)) {
        pg8::Gemm g{MIX, WOUT, MPROMPT, DM, DM}; pg8::StaticOrder S; S.init(MPROMPT, DM, C.G, C.bid, WGM_N2K);
        pg8::EpiG3 E{x_prompt, X1B, A3, norm_ffn, SS};
        pg8::gemm_phase<pg8::EpiG3, pg8::StaticOrder, true, true>(C.lds, g, S, E);
        const size_t ro = (size_t)MPROMPT * 2048;
        SkG3 e{x_sample, X1 + ro, X1B + ro, norm_ffn, SS + MPROMPT}; skinny_phase<1, SkG3>(C, MIX + ro, WOUT, DM, DM, e);
        SEAM(6); DUMP(6);
    }
    if (IN(7)) {
        pg8::Gemm g{X1B, WUP, MPROMPT, DFF, DM}; pg8::StaticOrder S; S.init(MPROMPT, DFF, C.G, C.bid, WGM_UP);
        pg8::EpiUp E{H, SS};
        REPS(7) pg8::gemm_phase<pg8::EpiUp, pg8::StaticOrder, true, true>(C.lds, g, S, E);
        SkUp e{H + (size_t)MPROMPT * 8192, SS + MPROMPT}; REPS(11) skinny_phase<4, SkUp>(C, X1B + (size_t)MPROMPT * 2048, WUP, DFF, DM, e);
        SEAM(7); DUMP(7);
    }
    if (IN(8)) {
        pg8::Gemm g{H, WDN, MPROMPT, DM, DFF}; pg8::StaticOrder S; S.init(MPROMPT, DM, C.G, C.bid, WGM_N2K);
        if (C.G == 256) { pg8::EpiDownLn E{X1, X1B, norm_final, (float*)(ws + WS_SS2), (unsigned*)(ws + WS_PCNT), C.lds + 131072 + 1024}; pg8::gemm_phase<pg8::EpiDownLn, pg8::StaticOrder, true, true>(C.lds, g, S, E); }
        else { pg8::EpiDown E{X1, X1B}; pg8::gemm_phase<pg8::EpiDown, pg8::StaticOrder, true, true>(C.lds, g, S, E); }
        SkDown e{X1 + (size_t)MPROMPT * 2048}; skinny_phase<1, SkDown>(C, H + (size_t)MPROMPT * 8192, WDN, DM, DFF, e);
        SEAM(8); DUMP(8);
    }
    if (IN(9)) {
        const int gw = C.bid * NWAVES + C.wave, NGW = C.G * NWAVES;
        for (int m = (C.G == 256 ? MPROMPT : 0) + gw; m < MTOT; m += NGW) {
            GAS f32x4* xr = (GAS f32x4*)(out + (size_t)m * DM) + C.lane; const GAS f32x4* gr = (const GAS f32x4*)norm_final + C.lane;
            f32x4 v[8]; float s = 0.f;
#pragma unroll
            for (int j = 0; j < 8; ++j) { v[j] = xr[64 * j]; s += (v[j].x * v[j].x + v[j].y * v[j].y) + (v[j].z * v[j].z + v[j].w * v[j].w); }
            const float rstd = __builtin_amdgcn_rsqf(wave_sum(s) * (1.f / DM) + EPS);
#pragma unroll
            for (int j = 0; j < 8; ++j) xr[64 * j] = v[j] * rstd * gr[64 * j];
        }
    }
#undef IN
#undef SEAM
}

#ifndef MK_SPLIT
#define MK_SPLIT 0
#endif
extern "C" void kernel_launch(void* const* d_in, const int* in_sizes, int n_in, void* d_out, int out_size, void* d_ws, size_t ws_size, hipStream_t stream) {
    static int grid = 0;
    if (grid == 0) {
        int dev = 0, cus = 0, per_cu = 0;
        if (n_in != 16 || ws_size < WS_END) { fprintf(stderr, "kernel_launch: unexpected n_in %d / ws_size %zu (need %zu)\n", n_in, ws_size, (size_t)WS_END); grid = -1; return; }
        if (hipGetDevice(&dev) != hipSuccess || hipDeviceGetAttribute(&cus, hipDeviceAttributeMultiprocessorCount, dev) != hipSuccess) { grid = -1; return; }
        if (hipFuncSetAttribute((const void*)mk_fwd, hipFuncAttributeMaxDynamicSharedMemorySize, LDS_BYTES) != hipSuccess) { fprintf(stderr, "kernel_launch: hipFuncSetAttribute failed\n"); grid = -1; return; }
        if (hipOccupancyMaxActiveBlocksPerMultiprocessor(&per_cu, (const void*)mk_fwd, NTHR, LDS_BYTES) != hipSuccess || per_cu < 1) { fprintf(stderr, "kernel_launch: occupancy query says %d\n", per_cu); per_cu = 1; }
        (void)hipGetLastError();
        grid = cus * per_cu;
        fprintf(stderr, "kernel_launch: grid %d (cus %d x %d), ws %zu\n", grid, cus, per_cu, ws_size);
    }
    if (grid < 0) return;
#ifdef DBG_POISON
    (void)hipMemsetAsync(d_ws, 0xAA, WS_END, stream); (void)hipMemsetAsync(d_out, 0xAA, (size_t)out_size * 4, stream);
#endif
    (void)hipMemsetAsync((char*)d_ws + WS_BAR, 0, WS_CTL_BYTES, stream);
    Args a{};
    for (int i = 0; i < 16; ++i) a.in[i] = (const float*)d_in[i];
    a.out = (float*)d_out; a.ws = (unsigned char*)d_ws;
#if MK_SPLIT
    for (int p = 0; p < NPHASE; ++p) {
        a.ph_lo = p; a.ph_hi = p + 1; void* kargs[] = {&a};
        hipError_t e = hipLaunchCooperativeKernel((const void*)mk_fwd, dim3(grid), dim3(NTHR), kargs, LDS_BYTES, stream);
        if (e != hipSuccess) { fprintf(stderr, "cooperative launch %d failed: %s (grid %d)\n", p, hipGetErrorString(e), grid); break; }
    }
#else
    a.ph_lo = 0; a.ph_hi = NPHASE; void* kargs[] = {&a};
    hipError_t e = hipLaunchCooperativeKernel((const void*)mk_fwd, dim3(grid), dim3(NTHR), kargs, LDS_BYTES, stream);
    if (e != hipSuccess) fprintf(stderr, "cooperative launch failed: %s (grid %d)\n", hipGetErrorString(e), grid);
#endif
}
```

```cpp
#include <hip/hip_runtime.h>
#include <hip/hip_cooperative_groups.h>
#include <cstdio>
#include <cstdint>
namespace cg = cooperative_groups;
namespace pg8 {
#define PG8_LAS __attribute__((address_space(3)))
typedef unsigned short bf16_t;
#define MFMA_SETTLE() asm volatile("s_nop 7\n\ts_nop 7\n\ts_nop 7" ::: "memory")
typedef short bf16x8 __attribute__((ext_vector_type(8)));
typedef float f32x4 __attribute__((ext_vector_type(4)));
typedef unsigned u32x4 __attribute__((ext_vector_type(4)));
constexpr int BM = 256, BK = 64, HALF = 128, HTB = HALF * BK * 2  , STAGE_BYTES = 8 * HTB, NXCD = 8, WGM = 8;

__host__ __device__ __forceinline__ int lds_byte(int r, int c) { const int st = (r >> 4) * 2 + (c >> 5), rr = r & 15, cc = c & 31, ob = rr * 64 + cc * 2; return st * 1024 + (ob ^ (((ob >> 9) & 1) << 5)); }
__host__ __device__ __forceinline__ void stage_rc(int b, int& R, int& C) { const int st = b / 1024, sb = b % 1024, swz = sb ^ (((sb >> 9) & 1) << 5); R = (st >> 1) * 16 + swz / 64; C = (st & 1) * 32 + (swz % 64) / 2; }
__host__ __device__ __forceinline__ int perm32(int rho) { const int n = rho >> 4, i = rho & 15; return 8 * (i >> 2) + 4 * n + (i & 3); }

struct Unit { int pm, pn; };
struct Gemm { const bf16_t* A; const bf16_t* Bt; int M, N, K; };

struct StaticOrder {
    int nM, nN, nwg, G, c, wgm;
    __host__ __device__ void init(int M, int N, int G_, int c_, int wgm_ = WGM) { nM = M / BM; nN = N / BM; nwg = nM * nN; G = G_; c = c_; wgm = wgm_; }
    __host__ __device__ bool next(int i, Unit& u) const {
        const long L = (long)i * G + c; if (L >= nwg) return false;
        int wgid = (int)L; { const int q = nwg / NXCD, r = nwg % NXCD, xcd = wgid % NXCD, off = wgid / NXCD; wgid = (xcd < r ? xcd * (q + 1) : r * (q + 1) + (xcd - r) * q) + off; }
        const int nig = wgm * nN, gid = wgid / nig, fm = gid * wgm, gsz = (nM - fm) < wgm ? (nM - fm) : wgm;
        u.pm = fm + ((wgid % nig) % gsz); u.pn = (wgid % nig) / gsz; return true;
    }
    __device__ __forceinline__ void a_ready(const Unit&) const {}
    __device__ __forceinline__ void done(const Unit&) const {}
};

__device__ __forceinline__ unsigned cvt_pk_bf16(float lo, float hi) { unsigned r; asm volatile("v_cvt_pk_bf16_f32 %0, %1, %2" : "=v"(r) : "v"(lo), "v"(hi)); return r; }
__device__ __forceinline__ u32x4 pack8(const f32x4 a, const f32x4 b) { u32x4 w; w.x = cvt_pk_bf16(a[0], a[1]); w.y = cvt_pk_bf16(a[2], a[3]); w.z = cvt_pk_bf16(b[0], b[1]); w.w = cvt_pk_bf16(b[2], b[3]); return w; }
__device__ __forceinline__ float bf_lo(unsigned w) { return __uint_as_float(w << 16); }
__device__ __forceinline__ float bf_hi(unsigned w) { return __uint_as_float(w & 0xffff0000u); }
__device__ __forceinline__ void unpack8(const u32x4 w, f32x4& a, f32x4& b) { a = (f32x4){bf_lo(w.x), bf_hi(w.x), bf_lo(w.y), bf_hi(w.y)}; b = (f32x4){bf_lo(w.z), bf_hi(w.z), bf_lo(w.w), bf_hi(w.w)}; }
__device__ __forceinline__ float sigm(float x) { return __builtin_amdgcn_rcpf(1.0f + __expf(-x)); }
constexpr int MP = 8448, MPROMPT = 8192, MTOT = 8320;
struct EpiG1 {
    static constexpr bool PERM = true, AFTER_DRAIN = false, HAS_MID = false;
    bf16_t *U, *BG, *Q, *IV, *OG, *R, *GBS; float* LOGF; const float* lbl; float* ncp; float* ncs;
    __device__ __forceinline__ void mid(f32x4 (&)[2][2][4][2], const Unit&, int, int, int, int) const {}
    __device__ __forceinline__ void operator()(const f32x4 (&acc)[2][2][4][2], const Unit& u, int wr, int wc, int fr, int fq) const {
        const int pn = u.pn, row0 = u.pm * BM + wr * 64 + fr, cin = wc * 32 + 8 * fq;
        if (pn < 8) {
            const int col = 128 * pn + cin;
#pragma unroll
            for (int ai = 0; ai < 2; ++ai)
#pragma unroll
                for (int m = 0; m < 4; ++m) {
                    const int row = row0 + ai * HALF + m * 16;
                    const f32x4 v0 = acc[ai][0][m][0] * acc[ai][1][m][0], v1 = acc[ai][0][m][1] * acc[ai][1][m][1];
                    *(u32x4*)(U + (size_t)row * 1024 + col) = pack8(v0, v1);
                    if (row < MPROMPT) { const int t = row & 2047; if (t >= 2046) { float* p = ncp + ((size_t)((row >> 11) * 2 + (t - 2046))) * 1024 + col; *(f32x4*)p = v0; *(f32x4*)(p + 4) = v1; } }
                    else if (row < MTOT) { float* p = ncs + ((size_t)((row - MPROMPT) * 2 + 1)) * 1024 + col; *(f32x4*)p = v0; *(f32x4*)(p + 4) = v1; }
                }
        } else if (pn < 28) {
            const int ty = (pn - 8) >> 2, cb = ((pn - 8) & 3) * 256;
#pragma unroll
            for (int bj = 0; bj < 2; ++bj) {
                const int col = cb + bj * HALF + cin;
                f32x4 lb0 = (f32x4){0.f, 0.f, 0.f, 0.f}, lb1 = lb0;
                if (ty == 2) {
                    const f32x4 a0 = *(const f32x4*)(lbl + col), a1 = *(const f32x4*)(lbl + col + 4), b0 = *(const f32x4*)(lbl + 1024 + col), b1 = *(const f32x4*)(lbl + 1024 + col + 4);
#pragma unroll
                    for (int i = 0; i < 4; ++i) { lb0[i] = sigm(a0[i] - b0[i]); lb1[i] = sigm(a1[i] - b1[i]); }
                }
#pragma unroll
                for (int ai = 0; ai < 2; ++ai)
#pragma unroll
                    for (int m = 0; m < 4; ++m) {
                        const int row = row0 + ai * HALF + m * 16;
                        f32x4 v0 = acc[ai][bj][m][0], v1 = acc[ai][bj][m][1];
                        if (ty == 2) {
#pragma unroll
                            for (int i = 0; i < 4; ++i) { v0[i] = __logf(lb0[i] + (1.0f - lb0[i]) * sigm(v0[i])); v1[i] = __logf(lb1[i] + (1.0f - lb1[i]) * sigm(v1[i])); }
                            float* p = LOGF + (size_t)row * 1024 + col; *(f32x4*)p = v0; *(f32x4*)(p + 4) = v1;
                        } else {
                            if (ty == 1 || ty == 4) {
#pragma unroll
                                for (int i = 0; i < 4; ++i) { v0[i] = v0[i] * sigm(v0[i]); v1[i] = v1[i] * sigm(v1[i]); }
                            }
                            bf16_t* base = ty == 0 ? BG : (ty == 1 ? Q : (ty == 3 ? IV : OG));
                            *(u32x4*)(base + (size_t)row * 1024 + col) = pack8(v0, v1);
                        }
                    }
            }
        } else {
            const int col = 128 * (pn - 28) + cin;
#pragma unroll
            for (int ai = 0; ai < 2; ++ai)
#pragma unroll
                for (int m = 0; m < 4; ++m) {
                    const int row = row0 + ai * HALF + m * 16;
                    f32x4 r0, r1, g0, g1;
#pragma unroll
                    for (int i = 0; i < 4; ++i) {
                        const float ea0 = __expf(-acc[ai][0][m][0][i]), eb0 = __expf(-acc[ai][1][m][0][i]), ea1 = __expf(-acc[ai][0][m][1][i]), eb1 = __expf(-acc[ai][1][m][1][i]);
                        g0[i] = __builtin_amdgcn_rcpf(1.0f + eb0); g1[i] = __builtin_amdgcn_rcpf(1.0f + eb1);
                        r0[i] = (1.0f + eb0) * __builtin_amdgcn_rcpf(1.0f + ea0); r1[i] = (1.0f + eb1) * __builtin_amdgcn_rcpf(1.0f + ea1);
                    }
                    *(u32x4*)(R + (size_t)row * 2048 + col) = pack8(r0, r1);
                    *(u32x4*)(GBS + (size_t)row * 2048 + col) = pack8(g0, g1);
                }
        }
    }
};
struct EpiG2 {
    static constexpr bool PERM = true, AFTER_DRAIN = false, HAS_MID = true;
    const bf16_t *R, *GBS; bf16_t* MIX;
    __device__ __forceinline__ void mid(f32x4 (&acc)[2][2][4][2], const Unit& u, int wr, int wc, int fr, int fq) const {
        int row0 = u.pm * BM + wr * 64 + fr, col0 = u.pn * BM + wc * 32 + 8 * fq;
        asm volatile("" : "+v"(row0), "+v"(col0));
#pragma unroll
        for (int ai = 0; ai < 2; ++ai) {
            u32x4 w[4][2];
#pragma unroll
            for (int m = 0; m < 4; ++m)
#pragma unroll
                for (int bj = 0; bj < 2; ++bj) w[m][bj] = *(const u32x4*)(R + (size_t)(row0 + ai * HALF + m * 16) * 2048 + col0 + bj * HALF);
#pragma unroll
            for (int m = 0; m < 4; ++m)
#pragma unroll
                for (int bj = 0; bj < 2; ++bj) { f32x4 a, b; unpack8(w[m][bj], a, b); acc[ai][bj][m][0] *= a; acc[ai][bj][m][1] *= b; }
            asm volatile("" ::: "memory");
        }
    }
    __device__ __forceinline__ void operator()(const f32x4 (&acc)[2][2][4][2], const Unit& u, int wr, int wc, int fr, int fq) const {
        const int row0 = u.pm * BM + wr * 64 + fr, col0 = u.pn * BM + wc * 32 + 8 * fq;
#pragma unroll
        for (int ai = 0; ai < 2; ++ai) {
            u32x4 gw[4][2];
#pragma unroll
            for (int m = 0; m < 4; ++m)
#pragma unroll
                for (int bj = 0; bj < 2; ++bj) gw[m][bj] = *(const u32x4*)(GBS + (size_t)(row0 + ai * HALF + m * 16) * 2048 + col0 + bj * HALF);
#pragma unroll
            for (int m = 0; m < 4; ++m)
#pragma unroll
                for (int bj = 0; bj < 2; ++bj) {
                    const size_t off = (size_t)(row0 + ai * HALF + m * 16) * 2048 + col0 + bj * HALF;
                    f32x4 a, b; unpack8(gw[m][bj], a, b);
                    *(u32x4*)(MIX + off) = pack8(acc[ai][bj][m][0] * a, acc[ai][bj][m][1] * b);
                }
        }
    }
};
struct EpiG3 {
    static constexpr bool PERM = true, AFTER_DRAIN = false, HAS_MID = false;
    const float* X; bf16_t* X1B; bf16_t* A3; const float* g; float* ss;
    __device__ __forceinline__ void mid(f32x4 (&)[2][2][4][2], const Unit&, int, int, int, int) const {}
    __device__ __forceinline__ void operator()(const f32x4 (&acc)[2][2][4][2], const Unit& u, int wr, int wc, int fr, int fq) const {
        const int row0 = u.pm * BM + wr * 64 + fr, col0 = u.pn * BM + wc * 32 + 8 * fq;
#pragma unroll
        for (int ai = 0; ai < 2; ++ai) {
            f32x4 xa[4][2][2];
#pragma unroll
            for (int m = 0; m < 4; ++m)
#pragma unroll
                for (int bj = 0; bj < 2; ++bj) { const float* xp = X + (size_t)(row0 + ai * HALF + m * 16) * 2048 + col0 + bj * HALF; xa[m][bj][0] = *(const f32x4*)xp; xa[m][bj][1] = *(const f32x4*)(xp + 4); }
#pragma unroll
            for (int m = 0; m < 4; ++m) {
                const int row = row0 + ai * HALF + m * 16; float s = 0.f;
#pragma unroll
                for (int bj = 0; bj < 2; ++bj) {
                    const size_t off = (size_t)row * 2048 + col0 + bj * HALF;
                    const f32x4 x0 = xa[m][bj][0] + acc[ai][bj][m][0], x1 = xa[m][bj][1] + acc[ai][bj][m][1];
                    *(u32x4*)(X1B + off) = pack8(x0, x1);
                    s += (x0[0] * x0[0] + x0[1] * x0[1]) + (x0[2] * x0[2] + x0[3] * x0[3]) + (x1[0] * x1[0] + x1[1] * x1[1]) + (x1[2] * x1[2] + x1[3] * x1[3]);
                }
                s += __shfl_xor(s, 16); s += __shfl_xor(s, 32);
                if (fq == 0) atomicAdd(ss + row, s);
            }
        }
    }
};
struct EpiUp {
    static constexpr bool PERM = true, AFTER_DRAIN = false, HAS_MID = false;
    bf16_t* H; const float* ss;
    __device__ __forceinline__ void mid(f32x4 (&)[2][2][4][2], const Unit&, int, int, int, int) const {}
    __device__ __forceinline__ void operator()(const f32x4 (&acc)[2][2][4][2], const Unit& u, int wr, int wc, int fr, int fq) const {
        const int row0 = u.pm * BM + wr * 64 + fr, col0 = u.pn * BM + wc * 32 + 8 * fq;
        float rsv[2][4];
#pragma unroll
        for (int ai = 0; ai < 2; ++ai)
#pragma unroll
            for (int m = 0; m < 4; ++m) rsv[ai][m] = ss[row0 + ai * HALF + m * 16];
#pragma unroll
        for (int ai = 0; ai < 2; ++ai)
#pragma unroll
            for (int m = 0; m < 4; ++m) {
                const int row = row0 + ai * HALF + m * 16;
                const float rs = __builtin_amdgcn_rsqf(rsv[ai][m] * (1.0f / 2048.0f) + 1e-6f);
#pragma unroll
                for (int bj = 0; bj < 2; ++bj) {
                    f32x4 v0 = acc[ai][bj][m][0] * rs, v1 = acc[ai][bj][m][1] * rs;
#pragma unroll
                    for (int i = 0; i < 4; ++i) { const float a = fmaxf(v0[i], 0.f), b = fmaxf(v1[i], 0.f); v0[i] = a * a; v1[i] = b * b; }
                    *(u32x4*)(H + (size_t)row * 8192 + col0 + bj * HALF) = pack8(v0, v1);
                }
            }
    }
};
struct EpiDown {
    static constexpr bool PERM = true, AFTER_DRAIN = false, HAS_MID = false;
    float* X1; const bf16_t* X1B;
    __device__ __forceinline__ void mid(f32x4 (&)[2][2][4][2], const Unit&, int, int, int, int) const {}
    __device__ __forceinline__ void operator()(const f32x4 (&acc)[2][2][4][2], const Unit& u, int wr, int wc, int fr, int fq) const {
        const int row0 = u.pm * BM + wr * 64 + fr, col0 = u.pn * BM + wc * 32 + 8 * fq;
#pragma unroll
        for (int ai = 0; ai < 2; ++ai)
#pragma unroll
            for (int m = 0; m < 4; ++m)
#pragma unroll
                for (int bj = 0; bj < 2; ++bj) {
                    const size_t off = (size_t)(row0 + ai * HALF + m * 16) * 2048 + col0 + bj * HALF; float* p = X1 + off;
                    f32x4 b0, b1; unpack8(*(const u32x4*)(X1B + off), b0, b1);
                    const f32x4 x0 = b0 + acc[ai][bj][m][0], x1 = b1 + acc[ai][bj][m][1];
                    *(f32x4*)p = x0; *(f32x4*)(p + 4) = x1;
                }
    }
};
struct EpiDownLn {
    static constexpr bool PERM = true, AFTER_DRAIN = false, HAS_MID = false;
    float* X1; const bf16_t* X1B; const float* g; float* ss2; unsigned* cnt; PG8_LAS unsigned char* ldsx;
    __device__ __forceinline__ void mid(f32x4 (&)[2][2][4][2], const Unit&, int, int, int, int) const {}
    __device__ __forceinline__ void operator()(f32x4 (&acc)[2][2][4][2], const Unit& u, int wr, int wc, int fr, int fq) const {
        const int row0 = u.pm * BM + wr * 64 + fr, col0 = u.pn * BM + wc * 32 + 8 * fq;
#pragma unroll
        for (int ai = 0; ai < 2; ++ai)
#pragma unroll
            for (int m = 0; m < 4; ++m) {
                const int row = row0 + ai * HALF + m * 16; float s = 0.f;
#pragma unroll
                for (int bj = 0; bj < 2; ++bj) {
                    f32x4 b0, b1; unpack8(*(const u32x4*)(X1B + (size_t)row * 2048 + col0 + bj * HALF), b0, b1);
                    const f32x4 x0 = b0 + acc[ai][bj][m][0], x1 = b1 + acc[ai][bj][m][1];
                    acc[ai][bj][m][0] = x0; acc[ai][bj][m][1] = x1;
                    s += (x0[0] * x0[0] + x0[1] * x0[1]) + (x0[2] * x0[2] + x0[3] * x0[3]) + (x1[0] * x1[0] + x1[1] * x1[1]) + (x1[2] * x1[2] + x1[3] * x1[3]);
                }
                s += __shfl_xor(s, 16); s += __shfl_xor(s, 32);
                if (fq == 0) atomicAdd(ss2 + row, s);
            }
        asm volatile("s_waitcnt vmcnt(0)" ::: "memory");
        __builtin_amdgcn_s_barrier(); asm volatile("" ::: "memory");
        PG8_LAS float* RS = (PG8_LAS float*)(ldsx);
        unsigned* c = cnt + 64 * u.pm;
        if (threadIdx.x < 64) {
            if (threadIdx.x == 0) __hip_atomic_fetch_add(c, 1u, __ATOMIC_RELAXED, __HIP_MEMORY_SCOPE_AGENT);
            for (unsigned sp = 0; sp < (1u << 22); ++sp) {
                if ((unsigned)__builtin_amdgcn_readfirstlane(__hip_atomic_load(c, __ATOMIC_RELAXED, __HIP_MEMORY_SCOPE_AGENT)) >= 8u) break;
                __builtin_amdgcn_s_sleep(2);
            }
#pragma unroll
            for (int j = 0; j < 4; ++j) {
                const int r = (int)threadIdx.x * 4 + j;
                const float tot = __hip_atomic_fetch_add(ss2 + u.pm * BM + r, 0.0f, __ATOMIC_RELAXED, __HIP_MEMORY_SCOPE_AGENT);
                RS[r] = __builtin_amdgcn_rsqf(tot * (1.0f / 2048.0f) + 1e-6f);
            }
        }
        asm volatile("s_waitcnt vmcnt(0) lgkmcnt(0)" ::: "memory"); __builtin_amdgcn_s_barrier(); asm volatile("" ::: "memory");
        f32x4 gv[2][2];
#pragma unroll
        for (int bj = 0; bj < 2; ++bj) { gv[bj][0] = *(const f32x4*)(g + col0 + bj * HALF); gv[bj][1] = *(const f32x4*)(g + col0 + bj * HALF + 4); }
#pragma unroll
        for (int ai = 0; ai < 2; ++ai)
#pragma unroll
            for (int m = 0; m < 4; ++m) {
                const int row = row0 + ai * HALF + m * 16;
                const float rs = RS[wr * 64 + fr + ai * HALF + m * 16];
#pragma unroll
                for (int bj = 0; bj < 2; ++bj) {
                    float* p = X1 + (size_t)row * 2048 + col0 + bj * HALF;
                    *(f32x4*)p = acc[ai][bj][m][0] * rs * gv[bj][0]; *(f32x4*)(p + 4) = acc[ai][bj][m][1] * rs * gv[bj][1];
                }
            }
    }
};
template <class Epi, class Sched, bool ALIGN_EPI = false, bool SP2 = false>
__device__ __forceinline__ void gemm_phase(PG8_LAS unsigned char* lds, const Gemm g, const Sched& S, const Epi& E) {
    const int tid = threadIdx.x, wid = __builtin_amdgcn_readfirstlane(tid >> 6), lane = tid & 63, wr = wid >> 2, wc = wid & 3, fr = lane & 15, fq = lane >> 4;
    const int K = g.K, nt = K / BK;
    unsigned voffA[2], voffB[2];
#pragma unroll
    for (int i = 0; i < 2; ++i) { int R, C; stage_rc(tid * 16 + i * 8192, R, C); const int Rb = Epi::PERM ? ((R & ~31) + perm32(R & 31)) : R;
        voffA[i] = (unsigned)(R * K + C) * 2u; voffB[i] = (unsigned)(Rb * K + C) * 2u; }
    const size_t kstep = (size_t)(BK * 2);
    const size_t hstep = (size_t)HALF * K * 2;
    const size_t tstep = 2 * hstep;
    const unsigned ldsw = (unsigned)wid * 1024u;
    const int aoff = lds_byte(wr * 64 + fr, fq * 8), boff = lds_byte(wc * 32 + fr, fq * 8);
#define PG8_SA(b, h) (((b) * 2 + (h)) * HTB)
#define PG8_SB(b, h) ((4 + (b) * 2 + (h)) * HTB)
#define PG8_STAGE(bufoff, gbase, voff) do { _Pragma("unroll") for (int _i = 0; _i < 2; ++_i) \
        __builtin_amdgcn_global_load_lds((const unsigned*)((const char*)(gbase) + (voff)[_i]), (PG8_LAS unsigned*)(lds + (bufoff) + ldsw + _i * 8192), 16, 0, 0); } while (0)
#define PG8_LDA(dst, b, h) do { _Pragma("unroll") for (int m = 0; m < 4; ++m) _Pragma("unroll") for (int k = 0; k < 2; ++k) dst[m][k] = *(const PG8_LAS bf16x8*)(lds + PG8_SA(b, h) + aoff + m * 2048 + k * 1024); } while (0)
#define PG8_LDB(dst, b, h) do { _Pragma("unroll") for (int n = 0; n < 2; ++n) _Pragma("unroll") for (int k = 0; k < 2; ++k) dst[n][k] = *(const PG8_LAS bf16x8*)(lds + PG8_SB(b, h) + boff + n * 2048 + k * 1024); } while (0)
#define PG8_MMA(ai, bj, At, Bt) do { __builtin_amdgcn_s_setprio(1); _Pragma("unroll") for (int m = 0; m < 4; ++m) _Pragma("unroll") for (int n = 0; n < 2; ++n) _Pragma("unroll") for (int k = 0; k < 2; ++k) \
        acc[ai][bj][m][n] = __builtin_amdgcn_mfma_f32_16x16x32_bf16(Bt[n][k], At[m][k], acc[ai][bj][m][n], 0, 0, 0); __builtin_amdgcn_s_setprio(0); } while (0)
#define PG8_WAIT_V(n) asm volatile("s_waitcnt vmcnt(" #n ")" ::: "memory")
#define PG8_WAIT_L(n) asm volatile("s_waitcnt lgkmcnt(" #n ")" ::: "memory")
#define PG8_BAR __builtin_amdgcn_s_barrier()
#define PG8_SCHED __builtin_amdgcn_sched_barrier(0)
    Unit cur, nxt; int ui = 0;
    if (!S.next(0, cur)) return;
    f32x4 acc[2][2][4][2];
#pragma unroll
    for (int a = 0; a < 2; ++a)
#pragma unroll
        for (int b = 0; b < 2; ++b)
#pragma unroll
            for (int m = 0; m < 4; ++m)
#pragma unroll
                for (int n = 0; n < 2; ++n) acc[a][b][m][n] = (f32x4){0.f, 0.f, 0.f, 0.f};
    bf16x8 At[4][2], B0[2][2], B1[2][2];
    const char* cA = (const char*)g.A + (size_t)cur.pm * tstep; const char* cB = (const char*)g.Bt + (size_t)cur.pn * tstep;
    S.a_ready(cur);
    if constexpr (SP2) {
        PG8_STAGE(PG8_SB(0, 0), cB, voffB); PG8_STAGE(PG8_SB(0, 1), cB + hstep, voffB); PG8_STAGE(PG8_SA(0, 0), cA, voffA); PG8_STAGE(PG8_SA(0, 1), cA + hstep, voffA);
        if (wr == 1) PG8_BAR;
        PG8_WAIT_V(2); PG8_BAR;
        PG8_STAGE(PG8_SB(1, 0), cB + kstep, voffB); PG8_STAGE(PG8_SA(1, 0), cA + kstep, voffA); PG8_STAGE(PG8_SB(1, 1), cB + hstep + kstep, voffB);
        PG8_WAIT_V(6); PG8_BAR;
    } else {
        PG8_STAGE(PG8_SB(0, 0), cB, voffB); PG8_STAGE(PG8_SA(0, 0), cA, voffA); PG8_STAGE(PG8_SB(0, 1), cB + hstep, voffB); PG8_STAGE(PG8_SA(0, 1), cA + hstep, voffA);
        if (wr == 1) PG8_BAR;
        PG8_WAIT_V(4); PG8_BAR;
        PG8_STAGE(PG8_SB(1, 0), cB + kstep, voffB); PG8_STAGE(PG8_SA(1, 0), cA + kstep, voffA); PG8_STAGE(PG8_SB(1, 1), cB + hstep + kstep, voffB);
        PG8_WAIT_V(6); PG8_BAR;
    }
    for (;;) {
        const bool has_next = S.next(ui + 1, nxt);
        const char* nA = has_next ? (const char*)g.A + (size_t)nxt.pm * tstep : cA; const char* nB = has_next ? (const char*)g.Bt + (size_t)nxt.pn * tstep : cB;
        for (int t = 0; t < nt; t += 2) {
            const bool last = (t == nt - 2);
            if constexpr (Epi::HAS_MID) { if (t == (nt >> 1)) { MFMA_SETTLE(); E.mid(acc, cur, wr, wc, fr, fq); } }
            const char* a1 = cA + (size_t)(t + 1) * kstep;
            const char* a2 = last ? nA : cA + (size_t)(t + 2) * kstep; const char* b2 = last ? nB : cB + (size_t)(t + 2) * kstep;
            const char* a3 = a2 + kstep; const char* b3 = b2 + kstep;
            if (last && has_next) S.a_ready(nxt);
            if constexpr (SP2) {
            PG8_LDB(B0, 0, 0); PG8_LDB(B1, 0, 1); PG8_SCHED; PG8_LDA(At, 0, 0); PG8_STAGE(PG8_SA(1, 1), a1 + hstep, voffA);
            PG8_WAIT_V(8); PG8_WAIT_L(0); PG8_BAR; PG8_MMA(0, 0, At, B0); PG8_MMA(0, 1, At, B1); PG8_BAR; PG8_SCHED;
            PG8_LDA(At, 0, 1); PG8_STAGE(PG8_SB(0, 0), b2, voffB); PG8_STAGE(PG8_SB(0, 1), b2 + hstep, voffB); PG8_STAGE(PG8_SA(0, 0), a2, voffA);
            PG8_WAIT_V(8); PG8_WAIT_L(0); PG8_BAR; PG8_MMA(1, 0, At, B0); PG8_MMA(1, 1, At, B1); PG8_BAR; PG8_SCHED;
            PG8_LDB(B0, 1, 0); PG8_LDB(B1, 1, 1); PG8_SCHED; PG8_LDA(At, 1, 0); PG8_STAGE(PG8_SA(0, 1), a2 + hstep, voffA);
            PG8_WAIT_V(8); PG8_WAIT_L(0); PG8_BAR; PG8_MMA(0, 0, At, B0); PG8_MMA(0, 1, At, B1); PG8_BAR; PG8_SCHED;
            PG8_LDA(At, 1, 1); PG8_STAGE(PG8_SB(1, 0), b3, voffB); PG8_STAGE(PG8_SB(1, 1), b3 + hstep, voffB); PG8_STAGE(PG8_SA(1, 0), a3, voffA);
            PG8_WAIT_V(8); PG8_WAIT_L(0); PG8_BAR; PG8_MMA(1, 0, At, B0); PG8_MMA(1, 1, At, B1); PG8_BAR; PG8_SCHED;
            } else {
            PG8_LDB(B0, 0, 0); PG8_SCHED; PG8_LDA(At, 0, 0); PG8_STAGE(PG8_SA(1, 1), a1 + hstep, voffA);
            PG8_WAIT_L(8); PG8_BAR; PG8_WAIT_L(0); PG8_MMA(0, 0, At, B0); PG8_BAR; PG8_SCHED;
            PG8_LDB(B1, 0, 1); PG8_STAGE(PG8_SB(0, 0), b2, voffB);
            PG8_BAR; PG8_WAIT_L(0); PG8_MMA(0, 1, At, B1); PG8_BAR;
            PG8_LDA(At, 0, 1); PG8_STAGE(PG8_SA(0, 0), a2, voffA);
            PG8_BAR; PG8_WAIT_L(0); PG8_MMA(1, 0, At, B0); PG8_BAR; PG8_SCHED;
            PG8_STAGE(PG8_SB(0, 1), b2 + hstep, voffB);
            PG8_WAIT_V(6); PG8_BAR; PG8_MMA(1, 1, At, B1); PG8_BAR;
            PG8_LDB(B0, 1, 0); PG8_SCHED; PG8_LDA(At, 1, 0); PG8_STAGE(PG8_SA(0, 1), a2 + hstep, voffA);
            PG8_WAIT_L(8); PG8_BAR; PG8_WAIT_L(0); PG8_MMA(0, 0, At, B0); PG8_BAR; PG8_SCHED;
            PG8_LDB(B1, 1, 1); PG8_STAGE(PG8_SB(1, 0), b3, voffB);
            PG8_BAR; PG8_WAIT_L(0); PG8_MMA(0, 1, At, B1); PG8_BAR;
            PG8_LDA(At, 1, 1); PG8_STAGE(PG8_SA(1, 0), a3, voffA);
            PG8_BAR; PG8_WAIT_L(0); PG8_MMA(1, 0, At, B0); PG8_BAR; PG8_SCHED;
            PG8_STAGE(PG8_SB(1, 1), b3 + hstep, voffB);
            PG8_WAIT_V(6); PG8_BAR; PG8_MMA(1, 1, At, B1); PG8_BAR;
            }
        }
        if constexpr (ALIGN_EPI) { if (wr == 0) PG8_BAR; }
        if constexpr (!Epi::AFTER_DRAIN) { MFMA_SETTLE(); E(acc, cur, wr, wc, fr, fq); S.done(cur); }
        if (!has_next) break;
#pragma unroll
        for (int a = 0; a < 2; ++a)
#pragma unroll
            for (int b = 0; b < 2; ++b)
#pragma unroll
                for (int m = 0; m < 4; ++m)
#pragma unroll
                    for (int n = 0; n < 2; ++n) acc[a][b][m][n] = (f32x4){0.f, 0.f, 0.f, 0.f};
        cur = nxt; cA = nA; cB = nB; ++ui;
        if constexpr (ALIGN_EPI) { if (wr == 1) PG8_BAR; }
    }
    PG8_WAIT_V(0);
    if constexpr (!ALIGN_EPI) { if (wr == 0) PG8_BAR; }
    PG8_BAR;
    if constexpr (Epi::AFTER_DRAIN) { E.fused(acc, cur, wr, wc, fr, fq, lds, wid, lane); S.done(cur); }
#undef PG8_SA
#undef PG8_SB
#undef PG8_STAGE
#undef PG8_LDA
#undef PG8_LDB
#undef PG8_MMA
#undef PG8_WAIT_V
#undef PG8_WAIT_L
#undef PG8_BAR
#undef PG8_SCHED
}
}
using pg8::MP; using pg8::MPROMPT; using pg8::MTOT;
constexpr int NWAVES = 8, NTHR = 512;
constexpr int DM = 2048, NIN = 11264, DFF = 8192, NSAMP = 128;
constexpr float EPS = 1e-6f;
constexpr size_t MiB = 1u << 20;
constexpr size_t SZ1 = (size_t)MP * 1024 * 2;
constexpr size_t WS_SS = 0, WS_SS2 = 36864, WS_DEC = 256 * 1024;
constexpr size_t WS_WIN = 1 * MiB, WS_WAB = 45 * MiB, WS_WOUT = 53 * MiB, WS_WUP = 61 * MiB, WS_WDN = 93 * MiB;
constexpr size_t WS_XN = 125 * MiB;
constexpr size_t WS_U = 158 * MiB, WS_BG = WS_U + SZ1, WS_LOGF = WS_U + 2 * SZ1, WS_Q = WS_U + 4 * SZ1, WS_IV = WS_U + 5 * SZ1, WS_OG = WS_U + 6 * SZ1, WS_KIN = WS_U + 7 * SZ1;
constexpr size_t WS_R = WS_U + 8 * SZ1, WS_GBS = WS_U + 10 * SZ1, WS_QIN = WS_U + 12 * SZ1, WS_END = WS_U + 13 * SZ1;
constexpr size_t WS_X1B = WS_WIN;
constexpr size_t WS_ST = WS_WIN;
constexpr size_t WS_MIX = WS_U;
constexpr size_t WS_A3 = WS_LOGF;
constexpr size_t WS_H = WS_Q;
static_assert(WS_END <= 378 * MiB, "ws map");
constexpr size_t O_YP = 0, O_YS = 16777216, O_NCP = 17039360, O_NHP = 17047552, O_NCS = 17571840, O_NHS = 17833984;
constexpr int LDS_BYTES = 139264;

#define GAS __attribute__((address_space(1)))
#define LAS __attribute__((address_space(3)))
typedef unsigned short bf16;
typedef unsigned v4u __attribute__((ext_vector_type(4)));
typedef unsigned v2u __attribute__((ext_vector_type(2)));
typedef float f32x4 __attribute__((ext_vector_type(4)));
typedef short bf16x8 __attribute__((ext_vector_type(8)));
#define LDS_WAIT() asm volatile("s_waitcnt lgkmcnt(0)" ::: "memory")
__device__ __forceinline__ unsigned f2bf(float f) { unsigned u = __builtin_bit_cast(unsigned, f); return (u + 0x7fffu + ((u >> 16) & 1u)) >> 16; }
__device__ __forceinline__ unsigned pk2(float lo, float hi) { return f2bf(lo) | (f2bf(hi) << 16); }
__device__ __forceinline__ float bf2f(unsigned short h) { return __uint_as_float(((unsigned)h) << 16); }
__device__ __forceinline__ float wave_sum(float v) {
#pragma unroll
    for (int o = 1; o < 64; o <<= 1) v += __shfl_xor(v, o);
    return v;
}

#define RLX_AGENT __ATOMIC_RELAXED, __HIP_MEMORY_SCOPE_AGENT
constexpr size_t WS_BAR = 128 * 1024, WS_PCNT = WS_BAR + 16384, WS_CTL_BYTES = 32768;
#define XB_TMO      128
#define XB_XCNT(j)  (256  + 64 * (j))
#define XB_XSUB(j)  (1280 + 64 * (j))
#define XB_XGEN(j)  (2304 + 64 * (j))
#define XB_TOP      3328
#define XB_TOPGEN   3392
#define XCD_BAR_WORDS 3456
#define XB_SPIN_CAP (1u << 18)

__device__ __forceinline__ unsigned xb_ld(unsigned* p)              { return __hip_atomic_load(p, __ATOMIC_RELAXED, __HIP_MEMORY_SCOPE_AGENT); }
__device__ __forceinline__ unsigned xb_add(unsigned* p, unsigned v) { return __hip_atomic_fetch_add(p, v, __ATOMIC_RELAXED, __HIP_MEMORY_SCOPE_AGENT); }
__device__ __forceinline__ unsigned xb_xcc_id() { return (unsigned)__builtin_amdgcn_s_getreg((3 << 11) | 20) & 0xFu; }
#define XB_SPIN(cond, bar) do { unsigned _sp = 0; while (cond) { __builtin_amdgcn_s_sleep(1); \
    if ((++_sp & 255u) == 0u) { if (xb_ld(&(bar)[XB_TMO])) break; if (_sp > XB_SPIN_CAP) { atomicAdd(&(bar)[XB_TMO], 1u); break; } } } } while (0)

struct XcdBarrier {
    unsigned* bar; unsigned x;
    volatile LAS unsigned* st;
};

__device__ __forceinline__ XcdBarrier xcd_barrier_post(unsigned* bar, volatile LAS unsigned* st) {
    XcdBarrier b; b.bar = bar; b.x = xb_xcc_id(); b.st = st;
    if (threadIdx.x == 0) (void)xb_add(&bar[XB_XCNT(b.x)], 1u);
    return b;
}
__device__ __forceinline__ void xcd_barrier_complete(unsigned* bar, unsigned x, unsigned& nloc, unsigned& nx) {
    const unsigned G = gridDim.x * gridDim.y * gridDim.z;
    unsigned sum, cnt, mine, sp = 0u;
    for (;;) {
        sum = 0u; cnt = 0u; mine = 0u;
#pragma unroll
        for (unsigned j = 0; j < 16; ++j) { const unsigned c = xb_ld(&bar[XB_XCNT(j)]); sum += c; cnt += (c > 0u) ? 1u : 0u; mine = (j == x) ? c : mine; }
        if (sum == G) break;
        __builtin_amdgcn_s_sleep(1);
        if ((++sp & 255u) == 0u) { if (xb_ld(&bar[XB_TMO])) break; if (sp > XB_SPIN_CAP) { atomicAdd(&bar[XB_TMO], 1u); break; } }
    }
    nloc = mine > 0u ? mine : 1u; nx = cnt > 0u ? cnt : 1u;
}

__device__ __forceinline__ void xcd_barrier(const XcdBarrier& b) {
    asm volatile("s_waitcnt vmcnt(0)" ::: "memory");
    __syncthreads();
    if (threadIdx.x == 0) {
        unsigned* bar = b.bar;
        __builtin_amdgcn_s_waitcnt(0);
        unsigned nloc = b.st[0], nx = b.st[1];
        if (nloc == 0u) { xcd_barrier_complete(bar, b.x, nloc, nx); b.st[0] = nloc; b.st[1] = nx; }
        const unsigned old = xb_add(&bar[XB_XSUB(b.x)], 1u);
        const unsigned gen = old / nloc;
        if (old + 1u == (gen + 1u) * nloc) {
            __builtin_amdgcn_fence(__ATOMIC_RELEASE, "agent");
            asm volatile("s_waitcnt vmcnt(0)" ::: "memory");
            const unsigned og = xb_add(&bar[XB_TOP], 1u);
            const unsigned tg = og / nx;
            if (og + 1u == (tg + 1u) * nx) xb_add(&bar[XB_TOPGEN], 1u);
            else XB_SPIN(xb_ld(&bar[XB_TOPGEN]) == tg, bar);
            __builtin_amdgcn_fence(__ATOMIC_ACQUIRE, "agent");
            xb_add(&bar[XB_XGEN(b.x)], 1u);
            asm volatile("s_waitcnt vmcnt(0)" ::: "memory");
        } else {
            XB_SPIN(xb_ld(&bar[XB_XGEN(b.x)]) == gen, bar);
            __builtin_amdgcn_fence(__ATOMIC_ACQUIRE, "agent");
            asm volatile("s_waitcnt vmcnt(0)" ::: "memory");
        }
    }
    __syncthreads();
}

#ifndef WGM_G1
#define WGM_G1 8
#endif
#ifndef WGM_UP
#define WGM_UP 4
#endif
#ifndef WGM_N2K
#define WGM_N2K 4
#endif
struct Ctx { LAS unsigned char* lds; int tid, lane, wave, G, bid; };

__device__ __forceinline__ void p0_transpose_item(const float* W, int Nsrc, int k0, int n_src0, bf16* WT, int KT, int n_dst0, int k_dst0, LAS float* scr, int lane, const float* ks = nullptr) {
#pragma unroll 8
    for (int i = 0; i < 32; ++i) { const int kk = 2 * i + (lane >> 5); scr[kk * 33 + (lane & 31)] = __builtin_nontemporal_load(W + (size_t)(k0 + kk) * Nsrc + n_src0 + (lane & 31)); }
    LDS_WAIT(); asm volatile("" ::: "memory");
    const int c = lane & 7;
    f32x4 ka = (f32x4){1.f, 1.f, 1.f, 1.f}, kb = ka;
    if (ks) { ka = *(const f32x4*)(ks + k0 + 8 * c); kb = *(const f32x4*)(ks + k0 + 8 * c + 4); }
#pragma unroll
    for (int j = 0; j < 4; ++j) { const int n = (lane >> 3) + 8 * j; const LAS float* s = scr + (8 * c) * 33 + n;
        v4u o; o.x = pk2(s[0 * 33] * ka.x, s[1 * 33] * ka.y); o.y = pk2(s[2 * 33] * ka.z, s[3 * 33] * ka.w); o.z = pk2(s[4 * 33] * kb.x, s[5 * 33] * kb.y); o.w = pk2(s[6 * 33] * kb.z, s[7 * 33] * kb.w);
        *(GAS v4u*)(WT + (size_t)(n_dst0 + n) * KT + k_dst0 + 8 * c) = o; }
    LDS_WAIT(); asm volatile("" ::: "memory");
}
__device__ __forceinline__ int g1_src_col(int n) {
    const int tile = n >> 8, within = n & 255, half = within >> 7, i = within & 127;
    if (tile < 8) return (half ? 2048 : 0) + 128 * tile + i;
    if (tile < 28) { const int ty = (tile - 8) >> 2; const int base = ty == 0 ? 1024 : (ty == 1 ? 3072 : (ty == 2 ? 4096 : (ty == 3 ? 5120 : 6144))); return base + ((tile - 8) & 3) * 256 + within; }
    return (half ? 9216 : 7168) + 128 * (tile - 28) + i;
}
__device__ __forceinline__ void rms_row_to_bf16(const float* xrow, const float* g, bf16* orow, int lane) {
    const GAS f32x4* xr = (const GAS f32x4*)xrow + lane; const GAS f32x4* gr = (const GAS f32x4*)g + lane;
    f32x4 v[8]; float s = 0.f;
#pragma unroll
    for (int j = 0; j < 8; ++j) { v[j] = xr[64 * j]; s += (v[j].x * v[j].x + v[j].y * v[j].y) + (v[j].z * v[j].z + v[j].w * v[j].w); }
    const float rstd = __builtin_amdgcn_rsqf(wave_sum(s) * (1.f / DM) + EPS);
    GAS v2u* o8 = (GAS v2u*)orow + lane;
#pragma unroll
    for (int j = 0; j < 8; ++j) { const f32x4 gg = gr[64 * j]; v2u o; o.x = pk2(v[j].x * rstd * gg.x, v[j].y * rstd * gg.y); o.y = pk2(v[j].z * rstd * gg.z, v[j].w * rstd * gg.w); o8[64 * j] = o; }
}
struct P0Args { const float *xp, *xs, *nmix, *win, *wa, *wb, *wout, *wup, *wdn, *nffn; bf16 *WIN, *WAB, *WOUT, *WUP, *WDN, *XN; float* ss; };
__device__ __forceinline__ void p0_prologue(const Ctx& C, const P0Args& a) {
    LAS float* scr = (LAS float*)(C.lds + C.wave * 16384);
    const int gw = C.bid * NWAVES + C.wave, NGW = C.G * NWAVES;
    constexpr int I_IN = 32 * 352, I_A = 16 * 64, I_O = 32 * 64, I_UP = 32 * 256, I_DN = 128 * 64;
    constexpr int NITEMS = I_IN + 2 * I_A + I_O + I_UP + I_DN;
    for (int it = gw; it < NITEMS; it += NGW) {
        int r = it;
        if (r < I_IN) { const int kb = r / 352, nb = r % 352; p0_transpose_item(a.win, NIN, 64 * kb, g1_src_col(32 * nb), a.WIN, 2048, 32 * nb, 64 * kb, scr, C.lane); continue; } r -= I_IN;
        if (r < I_A) { const int kb = r / 64, nb = r % 64; p0_transpose_item(a.wa, 2048, 64 * kb, 32 * nb, a.WAB, 2048, 32 * nb, 64 * kb, scr, C.lane); continue; } r -= I_A;
        if (r < I_A) { const int kb = r / 64, nb = r % 64; p0_transpose_item(a.wb, 2048, 64 * kb, 32 * nb, a.WAB, 2048, 32 * nb, 1024 + 64 * kb, scr, C.lane); continue; } r -= I_A;
        if (r < I_O) { const int kb = r / 64, nb = r % 64; p0_transpose_item(a.wout, 2048, 64 * kb, 32 * nb, a.WOUT, 2048, 32 * nb, 64 * kb, scr, C.lane); continue; } r -= I_O;
        if (r < I_UP) { const int kb = r / 256, nb = r % 256; p0_transpose_item(a.wup, 8192, 64 * kb, 32 * nb, a.WUP, 2048, 32 * nb, 64 * kb, scr, C.lane, a.nffn  ); continue; } r -= I_UP;
        { const int kb = r / 64, nb = r % 64; p0_transpose_item(a.wdn, 2048, 64 * kb, 32 * nb, a.WDN, 8192, 32 * nb, 64 * kb, scr, C.lane); }
    }
    for (int m = gw; m < MP; m += NGW) {
        if (m < MPROMPT) rms_row_to_bf16(a.xp + (size_t)m * DM, a.nmix, a.XN + (size_t)m * DM, C.lane);
        else if (m < MTOT) rms_row_to_bf16(a.xs + (size_t)(m - MPROMPT) * DM, a.nmix, a.XN + (size_t)m * DM, C.lane);
        else { GAS v4u* o = (GAS v4u*)(a.XN + (size_t)m * DM) + C.lane;
#pragma unroll
            for (int j = 0; j < 4; ++j) o[64 * j] = (v4u){0u, 0u, 0u, 0u}; }
    }
    for (int i = C.bid * NTHR + C.tid; i < MP; i += C.G * NTHR) a.ss[i] = 0.f;
    for (int i = C.bid * NTHR + C.tid; i < MPROMPT; i += C.G * NTHR) a.ss[WS_SS2 / 4 + i] = 0.f;
}
struct P2Args { bf16 *U, *BG, *Q, *IV, *OG, *KIN, *A2, *ST, *QIN; float *LOGF, *DEC, *DT; const float *sconv, *shgrn, *convw, *onorm; float *ncs, *nhp, *nhs; };
#define MFMA16(a, b, c) __builtin_amdgcn_mfma_f32_16x16x32_bf16((a), (b), (c), 0, 0, 0)
__device__ __forceinline__ void p2a_chunk(const Ctx& C, const P2Args& a, int item) {
    const int h = item & 7, n = (item >> 3) & 31, b = item >> 8, r0 = b * 2048 + n * 64, c0 = h * 128;
    LAS float* segtot = (LAS float*)C.lds;
    LAS unsigned short* KE = (LAS unsigned short*)(C.lds + 2048);
    LAS unsigned short* VT = KE + 128 * 72;
    const int tid = C.tid, seg = tid >> 7, d = tid & 127;
    float lf[16], cs[16], qv[16]; float run = 0.f;
#pragma unroll
    for (int j = 0; j < 16; ++j) lf[j] = a.LOGF[(size_t)(r0 + seg * 16 + j) * 1024 + c0 + d];
#pragma unroll
    for (int j = 0; j < 16; ++j) qv[j] = bf2f(a.Q[(size_t)(r0 + seg * 16 + j) * 1024 + c0 + d]);
#pragma unroll
    for (int j = 0; j < 16; ++j) { run += lf[j]; cs[j] = run; }
    segtot[seg * 128 + d] = run;
    { const int t = tid >> 3;
#pragma unroll
      for (int cc = 0; cc < 2; ++cc) { const int ch = (tid & 7) * 2 + cc; const v4u w = *(const v4u*)(a.IV + (size_t)(r0 + t) * 1024 + c0 + ch * 8);
          LAS unsigned short* p = VT + (ch * 8) * 72 + t;
          p[0 * 72] = (unsigned short)(w.x & 0xffff); p[1 * 72] = (unsigned short)(w.x >> 16); p[2 * 72] = (unsigned short)(w.y & 0xffff); p[3 * 72] = (unsigned short)(w.y >> 16);
          p[4 * 72] = (unsigned short)(w.z & 0xffff); p[5 * 72] = (unsigned short)(w.z >> 16); p[6 * 72] = (unsigned short)(w.w & 0xffff); p[7 * 72] = (unsigned short)(w.w >> 16); } }
    __syncthreads();
    float pre = 0.f, tot = 0.f;
#pragma unroll
    for (int s = 0; s < 4; ++s) { const float v = segtot[s * 128 + d]; tot += v; if (s < seg) pre += v; }
#pragma unroll
    for (int j = 0; j < 16; ++j) {
        const int t = seg * 16 + j; const size_t gi = (size_t)(r0 + t) * 1024 + c0 + d;
        const float bb = pre + cs[j], k = 1.0f - __expf(lf[j]), q = qv[j];
        a.QIN[gi] = (bf16)f2bf(q * __expf(bb)); a.KIN[gi] = (bf16)f2bf(k * __expf(-bb));
        KE[d * 72 + t] = (unsigned short)f2bf(k * __expf(tot - bb));
    }
    if (seg == 0) a.DEC[(size_t)item * 128 + d] = __expf(tot);
    __syncthreads();
    const int w = C.wave, fr = C.lane & 15, fq = C.lane >> 4;
    const bf16x8 a0 = *(const LAS bf16x8*)(VT + (w * 16 + fr) * 72 + fq * 8), a1 = *(const LAS bf16x8*)(VT + (w * 16 + fr) * 72 + 32 + fq * 8);
    bf16* dt = (bf16*)a.DT + (size_t)item * 16384;
#pragma unroll
    for (int db = 0; db < 8; ++db) {
        const bf16x8 b0 = *(const LAS bf16x8*)(KE + (db * 16 + fr) * 72 + fq * 8), b1 = *(const LAS bf16x8*)(KE + (db * 16 + fr) * 72 + 32 + fq * 8);
        f32x4 acc = (f32x4){0.f, 0.f, 0.f, 0.f};
        acc = MFMA16(a0, b0, acc); acc = MFMA16(a1, b1, acc);
#pragma unroll
        for (int i = 0; i < 4; ++i) dt[(w * 16 + 4 * fq + i) * 128 + db * 16 + fr] = (bf16)f2bf(acc[i]);
    }
    __syncthreads();
}
__device__ __forceinline__ void p2a_sample(const Ctx& C, const P2Args& a, int it) {
    const int h = it & 7, i = it >> 3, c0 = h * 128; const size_t row = MPROMPT + i;
    LAS float* red = (LAS float*)C.lds;
    LAS float* wsum = red + 16 * 128;
    const int tid = C.tid, e = (tid & 31) * 4, dg = tid >> 5;
    const float* S0 = a.shgrn + (size_t)(i * 8 + h) * 16384; float* SN = a.nhs + (size_t)(i * 8 + h) * 16384;
    const v2u vw = *(const v2u*)(a.IV + row * 1024 + c0 + e);
    const f32x4 v4 = (f32x4){pg8::bf_lo(vw.x), pg8::bf_hi(vw.x), pg8::bf_lo(vw.y), pg8::bf_hi(vw.y)};
    f32x4 o = (f32x4){0.f, 0.f, 0.f, 0.f};
    f32x4 sv[8]; float fv[8], qv[8];
#pragma unroll
    for (int j = 0; j < 8; ++j) { const int d = dg * 8 + j; sv[j] = __builtin_nontemporal_load((const f32x4*)(S0 + d * 128 + e)); fv[j] = a.LOGF[row * 1024 + c0 + d]; qv[j] = bf2f(a.Q[row * 1024 + c0 + d]); }
#pragma unroll
    for (int j = 0; j < 8; ++j) {
        const int d = dg * 8 + j; const float f = __expf(fv[j]), k = 1.0f - f, q = qv[j];
        const f32x4 s = sv[j]; const f32x4 sn = s * f + v4 * k;
        __builtin_nontemporal_store(sn, (f32x4*)(SN + d * 128 + e)); o += sn * q;
    }
    *(LAS f32x4*)(red + dg * 128 + e) = o;
    __syncthreads();
    float oo = 0.f;
    if (tid < 128) {
#pragma unroll
        for (int g = 0; g < 16; ++g) oo += red[g * 128 + tid];
        const float ss = wave_sum(oo * oo); if (C.lane == 0) wsum[C.wave] = ss;
    }
    __syncthreads();
    if (tid < 128) {
        const float rstd = __builtin_amdgcn_rsqf((wsum[0] + wsum[1]) * (1.f / 128.f) + EPS);
        a.A2[row * 2048 + 1024 + c0 + tid] = (bf16)f2bf(oo * rstd * a.onorm[tid] * bf2f(a.OG[row * 1024 + c0 + tid]));
    }
    __syncthreads();
}
__device__ __forceinline__ void p2a_conv(const Ctx& C, const P2Args& a, int it) {
    const int row = it * 4 + (C.tid >> 7), c8 = (C.tid & 127) * 8;
    if (row >= MTOT) return;
    f32x4 u0a, u0b, u1a, u1b, u2a, u2b, ba, bb; const f32x4 z = (f32x4){0.f, 0.f, 0.f, 0.f};
    pg8::unpack8(*(const v4u*)(a.U + (size_t)row * 1024 + c8), u0a, u0b);
    pg8::unpack8(*(const v4u*)(a.BG + (size_t)row * 1024 + c8), ba, bb);
    if (row < MPROMPT) {
        const int t = row & 2047;
        if (t >= 1) pg8::unpack8(*(const v4u*)(a.U + (size_t)(row - 1) * 1024 + c8), u1a, u1b); else { u1a = z; u1b = z; }
        if (t >= 2) pg8::unpack8(*(const v4u*)(a.U + (size_t)(row - 2) * 1024 + c8), u2a, u2b); else { u2a = z; u2b = z; }
    } else {
        const int i = row - MPROMPT; const float* sc = a.sconv + (size_t)i * 2048 + c8;
        u2a = *(const f32x4*)sc; u2b = *(const f32x4*)(sc + 4); u1a = *(const f32x4*)(sc + 1024); u1b = *(const f32x4*)(sc + 1028);
        float* nc = a.ncs + (size_t)i * 2048 + c8; *(f32x4*)nc = u1a; *(f32x4*)(nc + 4) = u1b;
    }
    const float* cw = a.convw + c8;
    const f32x4 w0a = *(const f32x4*)cw, w0b = *(const f32x4*)(cw + 4), w1a = *(const f32x4*)(cw + 1024), w1b = *(const f32x4*)(cw + 1028), w2a = *(const f32x4*)(cw + 2048), w2b = *(const f32x4*)(cw + 2052);
    const f32x4 ra = ba * (w0a * u2a + w1a * u1a + w2a * u0a), rb = bb * (w0b * u2b + w1b * u1b + w2b * u0b);
    *(v4u*)(a.A2 + (size_t)row * 2048 + c8) = pg8::pack8(ra, rb);
}
__device__ __forceinline__ void p2a_phase(const Ctx& C, const P2Args& a) {
    constexpr int N_CH = 1024, N_SA = 1024, N_CV = (MTOT + 3) / 4;
    for (int it = C.bid; it < N_SA + N_CH + N_CV; it += C.G) {
        if (it < N_SA) p2a_sample(C, a, it);
        else if (it < N_SA + N_CH) p2a_chunk(C, a, it - N_SA);
        else p2a_conv(C, a, it - N_SA - N_CH);
    }
}
__device__ __forceinline__ void p2b_phase(const Ctx& C, const P2Args& a) {
    for (int gid = C.bid * NTHR + C.tid; gid < 131072; gid += C.G * NTHR) {
        const int d = (gid & 31) * 4, e = (gid >> 5) & 127, bh = gid >> 12, b = bh >> 3, h = bh & 7;
        f32x4 S = (f32x4){0.f, 0.f, 0.f, 0.f};
        for (int n0 = 0; n0 < 32; n0 += 8) {
            f32x4 dl[8], dc[8];
#pragma unroll
            for (int q = 0; q < 8; ++q) { const size_t item = (size_t)((b * 32 + n0 + q) * 8 + h); { const v2u dw = *(const v2u*)((const bf16*)a.DT + (item * 128 + e) * 128 + d); dl[q] = (f32x4){pg8::bf_lo(dw.x), pg8::bf_hi(dw.x), pg8::bf_lo(dw.y), pg8::bf_hi(dw.y)}; } dc[q] = *(const f32x4*)(a.DEC + item * 128 + d); }
#pragma unroll
            for (int q = 0; q < 8; ++q) {
                const size_t item = (size_t)((b * 32 + n0 + q) * 8 + h);
                v2u w; w.x = pk2(S[0], S[1]); w.y = pk2(S[2], S[3]);
                *(v2u*)(a.ST + (item * 128 + e) * 128 + d) = w;
                S = dc[q] * S + dl[q];
            }
        }
        float* o = a.nhp + ((size_t)bh * 128 + d) * 128 + e;
        o[0] = S[0]; o[128] = S[1]; o[256] = S[2]; o[384] = S[3];
    }
}
__device__ __forceinline__ void p2c_chunk(const Ctx& C, const P2Args& a, int item) {
    const int h = item & 7, n = (item >> 3) & 31, b = item >> 8, r0 = b * 2048 + n * 64, c0 = h * 128;
    LAS unsigned short* QS = (LAS unsigned short*)C.lds;
    LAS unsigned short* KS = QS + 64 * 136;
    LAS unsigned short* VT = KS + 64 * 136;
    LAS unsigned short* PS = VT + 128 * 72;
    LAS float* OS = (LAS float*)(PS + 64 * 72);
    LAS unsigned short* STS = (LAS unsigned short*)(OS + 64 * 132);
    const int tid = C.tid;
#pragma unroll
    for (int cc = 0; cc < 2; ++cc) {
        const int id = tid + cc * 512, t = id >> 4, ch = id & 15; const size_t gi = (size_t)(r0 + t) * 1024 + c0 + ch * 8;
        *(LAS v4u*)(QS + t * 136 + ch * 8) = *(const v4u*)(a.QIN + gi);
        *(LAS v4u*)(KS + t * 136 + ch * 8) = *(const v4u*)(a.KIN + gi);
        const v4u w = *(const v4u*)(a.IV + gi);
        LAS unsigned short* p = VT + (ch * 8) * 72 + t;
        p[0 * 72] = (unsigned short)(w.x & 0xffff); p[1 * 72] = (unsigned short)(w.x >> 16); p[2 * 72] = (unsigned short)(w.y & 0xffff); p[3 * 72] = (unsigned short)(w.y >> 16);
        p[4 * 72] = (unsigned short)(w.z & 0xffff); p[5 * 72] = (unsigned short)(w.z >> 16); p[6 * 72] = (unsigned short)(w.w & 0xffff); p[7 * 72] = (unsigned short)(w.w >> 16);
    }
    {
        const bf16* stg = a.ST + (size_t)item * 16384;
#pragma unroll
        for (int cc = 0; cc < 4; ++cc) { const int id = tid + cc * 512, e = id >> 4, ch = id & 15; *(LAS v4u*)(STS + e * 136 + ch * 8) = *(const v4u*)(stg + e * 128 + ch * 8); }
    }
    __syncthreads();
    const int w = C.wave, fr = C.lane & 15, fq = C.lane >> 4, lb = w >> 1;
    bf16x8 qa[4];
#pragma unroll
    for (int kk = 0; kk < 4; ++kk) qa[kk] = *(const LAS bf16x8*)(QS + (lb * 16 + fr) * 136 + kk * 32 + fq * 8);
#pragma unroll
    for (int sj = 0; sj < 2; ++sj) {
        const int sb = (w & 1) * 2 + sj; f32x4 acc = (f32x4){0.f, 0.f, 0.f, 0.f};
#pragma unroll
        for (int kk = 0; kk < 4; ++kk) acc = MFMA16(qa[kk], *(const LAS bf16x8*)(KS + (sb * 16 + fr) * 136 + kk * 32 + fq * 8), acc);
#pragma unroll
        for (int i = 0; i < 4; ++i) { const int l = lb * 16 + 4 * fq + i, s = sb * 16 + fr; PS[l * 72 + s] = (unsigned short)f2bf(s <= l ? acc[i] : 0.f); }
    }
    __syncthreads();
    const bf16x8 p0 = *(const LAS bf16x8*)(PS + (lb * 16 + fr) * 72 + fq * 8), p1 = *(const LAS bf16x8*)(PS + (lb * 16 + fr) * 72 + 32 + fq * 8);
#pragma unroll
    for (int ej = 0; ej < 4; ++ej) {
        const int eb = (w & 1) * 4 + ej; f32x4 acc = (f32x4){0.f, 0.f, 0.f, 0.f};
        acc = MFMA16(p0, *(const LAS bf16x8*)(VT + (eb * 16 + fr) * 72 + fq * 8), acc);
        acc = MFMA16(p1, *(const LAS bf16x8*)(VT + (eb * 16 + fr) * 72 + 32 + fq * 8), acc);
#ifndef DBG_NO_ST
#pragma unroll
        for (int kk = 0; kk < 4; ++kk) acc = MFMA16(qa[kk], *(const LAS bf16x8*)(STS + (eb * 16 + fr) * 136 + kk * 32 + fq * 8), acc);
#endif
#pragma unroll
        for (int i = 0; i < 4; ++i) OS[(lb * 16 + 4 * fq + i) * 132 + eb * 16 + fr] = acc[i];
    }
    __syncthreads();
    {
        const int l = tid >> 3, part = tid & 7; float v[16]; float ss = 0.f;
#pragma unroll
        for (int j = 0; j < 16; ++j) { v[j] = OS[l * 132 + part * 16 + j]; ss += v[j] * v[j]; }
        ss += __shfl_xor(ss, 1); ss += __shfl_xor(ss, 2); ss += __shfl_xor(ss, 4);
        const float rstd = __builtin_amdgcn_rsqf(ss * (1.f / 128.f) + EPS);
        const size_t row = (size_t)(r0 + l);
#pragma unroll
        for (int hh = 0; hh < 2; ++hh) {
            f32x4 ga, gb; pg8::unpack8(*(const v4u*)(a.OG + row * 1024 + c0 + part * 16 + hh * 8), ga, gb);
            const f32x4 na = *(const f32x4*)(a.onorm + part * 16 + hh * 8), nb = *(const f32x4*)(a.onorm + part * 16 + hh * 8 + 4);
            f32x4 ra, rb;
#pragma unroll
            for (int i = 0; i < 4; ++i) { ra[i] = v[hh * 8 + i] * rstd * na[i] * ga[i]; rb[i] = v[hh * 8 + 4 + i] * rstd * nb[i] * gb[i]; }
            *(v4u*)(a.A2 + row * 2048 + 1024 + c0 + part * 16 + hh * 8) = pg8::pack8(ra, rb);
        }
    }
    __syncthreads();
}
template <int RB, class Epi>
__device__ __forceinline__ void skinny_phase(const Ctx& C, const bf16* A, const bf16* Bt, int N, int K, const Epi& E) {
    const int ncb = N / 64, nrb = NSAMP / (16 * RB), nunits = ncb * nrb;
    const int w = C.wave, l = C.lane, fr = l & 15, fq = l >> 4, ks = K / 8;
    LAS float* red = (LAS float*)C.lds;
    for (int u = C.bid; u < nunits; u += C.G) {
        const int cb = u % ncb, rb = u / ncb;
        f32x4 acc[RB][4];
#pragma unroll
        for (int r = 0; r < RB; ++r)
#pragma unroll
            for (int c = 0; c < 4; ++c) acc[r][c] = (f32x4){0.f, 0.f, 0.f, 0.f};
        const bf16* ap = A + (size_t)(rb * 16 * RB + fr) * K + w * ks + fq * 8;
        const bf16* bp = Bt + (size_t)(cb * 64 + fr) * K + w * ks + fq * 8;
#pragma unroll 4
        for (int k = 0; k < ks; k += 32) {
            bf16x8 af[RB], bfr[4];
#pragma unroll
            for (int r = 0; r < RB; ++r) af[r] = *(const bf16x8*)(ap + (size_t)r * 16 * K + k);
#pragma unroll
            for (int c = 0; c < 4; ++c) bfr[c] = *(const bf16x8*)(bp + (size_t)c * 16 * K + k);
#pragma unroll
            for (int r = 0; r < RB; ++r)
#pragma unroll
                for (int c = 0; c < 4; ++c) acc[r][c] = MFMA16(bfr[c], af[r], acc[r][c]);
        }
        MFMA_SETTLE();
#pragma unroll
        for (int r = 0; r < RB; ++r)
#pragma unroll
            for (int c = 0; c < 4; ++c) *(LAS f32x4*)(red + ((w * RB * 4 + r * 4 + c) * 64 + l) * 4) = acc[r][c];
        __syncthreads();
        for (int s = C.tid; s < RB * 256; s += NTHR) {
            const int r = s >> 8, c = (s >> 6) & 3, ln = s & 63;
            f32x4 lo = (f32x4){0.f, 0.f, 0.f, 0.f}, hi = lo;
#pragma unroll
            for (int ww = 0; ww < 4; ++ww) { lo += *(const LAS f32x4*)(red + ((ww * RB * 4 + r * 4 + c) * 64 + ln) * 4); hi += *(const LAS f32x4*)(red + (((ww + 4) * RB * 4 + r * 4 + c) * 64 + ln) * 4); }
            E(rb * 16 * RB + r * 16 + (ln & 15), cb * 64 + c * 16 + 4 * (ln >> 4), lo, hi);
        }
        __syncthreads();
    }
}
__device__ __forceinline__ f32x4 ld4bf(const bf16* p) { const v2u w = *(const v2u*)p; return (f32x4){pg8::bf_lo(w.x), pg8::bf_hi(w.x), pg8::bf_lo(w.y), pg8::bf_hi(w.y)}; }
__device__ __forceinline__ void st4bf(bf16* p, const f32x4 v) { v2u w; w.x = pg8::cvt_pk_bf16(v[0], v[1]); w.y = pg8::cvt_pk_bf16(v[2], v[3]); *(v2u*)p = w; }
struct SkG2 { const bf16 *R, *GBS; bf16* MIX;
    __device__ __forceinline__ void operator()(int row, int col, f32x4 lo, f32x4 hi) const { const size_t o = (size_t)row * 2048 + col; st4bf(MIX + o, (lo * ld4bf(R + o) + hi) * ld4bf(GBS + o)); } };
struct SkG3 { const float* X; float* X1; bf16* A3; const float* g; float* ss;
    __device__ __forceinline__ void operator()(int row, int col, f32x4 lo, f32x4 hi) const { const size_t o = (size_t)row * 2048 + col;
        const f32x4 x1 = *(const f32x4*)(X + o) + lo + hi; *(f32x4*)(X1 + o) = x1; st4bf(A3 + o, x1);
        float s = (x1[0] * x1[0] + x1[1] * x1[1]) + (x1[2] * x1[2] + x1[3] * x1[3]); s += __shfl_xor(s, 16); s += __shfl_xor(s, 32);
        if ((threadIdx.x & 63) < 16) atomicAdd(ss + row, s); } };
struct SkUp { bf16* H; const float* ss;
    __device__ __forceinline__ void operator()(int row, int col, f32x4 lo, f32x4 hi) const { const float rs = __builtin_amdgcn_rsqf(ss[row] * (1.0f / 2048.0f) + EPS);
        f32x4 v = (lo + hi) * rs;
#pragma unroll
        for (int i = 0; i < 4; ++i) { const float t = fmaxf(v[i], 0.f); v[i] = t * t; }
        st4bf(H + (size_t)row * 8192 + col, v); } };
struct SkDown { float* X1;
    __device__ __forceinline__ void operator()(int row, int col, f32x4 lo, f32x4 hi) const { float* p = X1 + (size_t)row * 2048 + col; *(f32x4*)p = *(const f32x4*)p + lo + hi; } };

struct Args { const float* in[16]; float* out; unsigned char* ws; int ph_lo, ph_hi; };
constexpr int NPHASE = 10;
__global__ void __launch_bounds__(NTHR, 2) mk_fwd(Args args) {
    extern __shared__ __attribute__((aligned(16))) unsigned char lds_raw[];
    cg::grid_group grid = cg::this_grid();
    Ctx C; C.lds = (LAS unsigned char*)lds_raw; C.tid = threadIdx.x; C.lane = C.tid & 63; C.wave = __builtin_amdgcn_readfirstlane(C.tid >> 6); C.G = gridDim.x; C.bid = blockIdx.x;
    unsigned char* ws = args.ws; float* out = args.out;
    const float *x_prompt = args.in[0], *x_sample = args.in[1], *state_conv = args.in[2], *state_hgrn = args.in[3], *norm_mix = args.in[4], *w_in = args.in[5], *conv_w = args.in[6],
                *lb_logits = args.in[7], *onorm_g = args.in[8], *w_a = args.in[9], *w_b = args.in[10], *w_out = args.in[11], *norm_ffn = args.in[12], *w_up = args.in[13], *w_down = args.in[14], *norm_final = args.in[15];
    bf16 *WIN = (bf16*)(ws + WS_WIN), *WAB = (bf16*)(ws + WS_WAB), *WOUT = (bf16*)(ws + WS_WOUT), *WUP = (bf16*)(ws + WS_WUP), *WDN = (bf16*)(ws + WS_WDN);
    bf16 *XN = (bf16*)(ws + WS_XN), *U = (bf16*)(ws + WS_U), *BG = (bf16*)(ws + WS_BG), *Q = (bf16*)(ws + WS_Q), *IV = (bf16*)(ws + WS_IV), *OG = (bf16*)(ws + WS_OG), *KIN = (bf16*)(ws + WS_KIN), *QIN = (bf16*)(ws + WS_QIN), *A3 = (bf16*)(ws + WS_A3), *X1B = (bf16*)(ws + WS_X1B);
    bf16 *R = (bf16*)(ws + WS_R), *GBS = (bf16*)(ws + WS_GBS), *ST = (bf16*)(ws + WS_ST), *MIX = (bf16*)(ws + WS_MIX), *H = (bf16*)(ws + WS_H);
    float *LOGF = (float*)(ws + WS_LOGF), *SS = (float*)(ws + WS_SS), *DEC = (float*)(ws + WS_DEC), *DT = out + O_YP, *X1 = out + O_YP;
    { volatile LAS unsigned* misc = (volatile LAS unsigned*)(C.lds + 131072 + 512); if (C.tid < 2) misc[C.tid] = 0u; }
    __syncthreads();
    XcdBarrier xbar = xcd_barrier_post((unsigned*)(ws + WS_BAR), (volatile LAS unsigned*)(C.lds + 131072 + 512));
    if (args.ph_lo > 100) grid.sync();
    const int lo = args.ph_lo, hi = args.ph_hi;
#ifndef PH_MASK
#define PH_MASK 0x3ff
#endif
#define IN(k) (((PH_MASK >> (k)) & 1) && lo <= (k) && (k) < hi)
#ifndef REP_MASK
#define REP_MASK 0
#endif
#ifndef SEAM_REP
#define SEAM_REP 1
#endif
#ifdef DBG_DUMP_AFTER
#define DUMP(k) do { if ((k) == DBG_DUMP_AFTER) { xcd_barrier(xbar); for (size_t i_ = (size_t)C.bid * NTHR + C.tid; i_ < (size_t)MTOT * 2048; i_ += (size_t)C.G * NTHR) out[i_] = bf2f((DBG_DUMP_BUF)[i_]); } } while (0)
#else
#define DUMP(k) do {} while (0)
#endif
#define REPS(k) for (int rep_ = 0; rep_ < (((REP_MASK >> (k)) & 1) ? 2 : 1); ++rep_)
#define SEAM(k) do { if ((k) + 1 < hi) for (int sr_ = 0; sr_ < SEAM_REP; ++sr_) { xcd_barrier(xbar); } } while (0)
    if (IN(0)) { P0Args a{x_prompt, x_sample, norm_mix, w_in, w_a, w_b, w_out, w_up, w_down, norm_ffn, WIN, WAB, WOUT, WUP, WDN, XN, SS}; REPS(0) p0_prologue(C, a); SEAM(0); }
    if (IN(1)) {
        pg8::Gemm g{XN, WIN, MP, NIN, DM}; pg8::StaticOrder S; S.init(MP, NIN, C.G, C.bid, WGM_G1);
        pg8::EpiG1 E{U, BG, Q, IV, OG, R, GBS, LOGF, lb_logits, out + O_NCP, out + O_NCS};
        REPS(1) pg8::gemm_phase<pg8::EpiG1, pg8::StaticOrder, true, true>(C.lds, g, S, E);
        SEAM(1); DUMP(1);
    }
    P2Args p2{U, BG, Q, IV, OG, KIN, XN, ST, QIN, LOGF, DEC, DT, state_conv, state_hgrn, conv_w, onorm_g, out + O_NCS, out + O_NHP, out + O_NHS};
    if (IN(2)) { REPS(2) p2a_phase(C, p2); SEAM(2); DUMP(2); }
    if (IN(3)) { REPS(3) p2b_phase(C, p2); SEAM(3); DUMP(3); }
    if (IN(4)) { REPS(4) for (int it = C.bid; it < 1024; it += C.G) p2c_chunk(C, p2, it); SEAM(4); DUMP(4); }

    if (IN(5)) {
        pg8::Gemm g{XN, WAB, MPROMPT, DM, DM}; pg8::StaticOrder S; S.init(MPROMPT, DM, C.G, C.bid, WGM_N2K);
        pg8::EpiG2 E{R, GBS, MIX};
        REPS(5) pg8::gemm_phase<pg8::EpiG2, pg8::StaticOrder, true, true>(C.lds, g, S, E);
        const size_t ro = (size_t)MPROMPT * 2048;
        SkG2 e{R + ro, GBS + ro, MIX + ro}; REPS(10) skinny_phase<1, SkG2>(C, XN + ro, WAB, DM, DM, e);
        SEAM(5); DUMP(5);
    }
    if (IN(6)) {
        pg8::Gemm g{MIX, WOUT, MPROMPT, DM, DM}; pg8::StaticOrder S; S.init(MPROMPT, DM, C.G, C.bid, WGM_N2K);
        pg8::EpiG3 E{x_prompt, X1B, A3, norm_ffn, SS};
        pg8::gemm_phase<pg8::EpiG3, pg8::StaticOrder, true, true>(C.lds, g, S, E);
        const size_t ro = (size_t)MPROMPT * 2048;
        SkG3 e{x_sample, X1 + ro, X1B + ro, norm_ffn, SS + MPROMPT}; skinny_phase<1, SkG3>(C, MIX + ro, WOUT, DM, DM, e);
        SEAM(6); DUMP(6);
    }
    if (IN(7)) {
        pg8::Gemm g{X1B, WUP, MPROMPT, DFF, DM}; pg8::StaticOrder S; S.init(MPROMPT, DFF, C.G, C.bid, WGM_UP);
        pg8::EpiUp E{H, SS};
        REPS(7) pg8::gemm_phase<pg8::EpiUp, pg8::StaticOrder, true, true>(C.lds, g, S, E);
        SkUp e{H + (size_t)MPROMPT * 8192, SS + MPROMPT}; REPS(11) skinny_phase<4, SkUp>(C, X1B + (size_t)MPROMPT * 2048, WUP, DFF, DM, e);
        SEAM(7); DUMP(7);
    }
    if (IN(8)) {
        pg8::Gemm g{H, WDN, MPROMPT, DM, DFF}; pg8::StaticOrder S; S.init(MPROMPT, DM, C.G, C.bid, WGM_N2K);
        if (C.G == 256) { pg8::EpiDownLn E{X1, X1B, norm_final, (float*)(ws + WS_SS2), (unsigned*)(ws + WS_PCNT), C.lds + 131072 + 1024}; pg8::gemm_phase<pg8::EpiDownLn, pg8::StaticOrder, true, true>(C.lds, g, S, E); }
        else { pg8::EpiDown E{X1, X1B}; pg8::gemm_phase<pg8::EpiDown, pg8::StaticOrder, true, true>(C.lds, g, S, E); }
        SkDown e{X1 + (size_t)MPROMPT * 2048}; skinny_phase<1, SkDown>(C, H + (size_t)MPROMPT * 8192, WDN, DM, DFF, e);
        SEAM(8); DUMP(8);
    }
    if (IN(9)) {
        const int gw = C.bid * NWAVES + C.wave, NGW = C.G * NWAVES;
        for (int m = (C.G == 256 ? MPROMPT : 0) + gw; m < MTOT; m += NGW) {
            GAS f32x4* xr = (GAS f32x4*)(out + (size_t)m * DM) + C.lane; const GAS f32x4* gr = (const GAS f32x4*)norm_final + C.lane;
            f32x4 v[8]; float s = 0.f;
#pragma unroll
            for (int j = 0; j < 8; ++j) { v[j] = xr[64 * j]; s += (v[j].x * v[j].x + v[j].y * v[j].y) + (v[j].z * v[j].z + v[j].w * v[j].w); }
            const float rstd = __builtin_amdgcn_rsqf(wave_sum(s) * (1.f / DM) + EPS);
#pragma unroll
            for (int j = 0; j < 8; ++j) xr[64 * j] = v[j] * rstd * gr[64 * j];
        }
    }
#undef IN
#undef SEAM
}

#ifndef MK_SPLIT
#define MK_SPLIT 0
#endif
extern "C" void kernel_launch(void* const* d_in, const int* in_sizes, int n_in, void* d_out, int out_size, void* d_ws, size_t ws_size, hipStream_t stream) {
    static int grid = 0;
    if (grid == 0) {
        int dev = 0, cus = 0, per_cu = 0;
        if (n_in != 16 || ws_size < WS_END) { fprintf(stderr, "kernel_launch: unexpected n_in %d / ws_size %zu (need %zu)\n", n_in, ws_size, (size_t)WS_END); grid = -1; return; }
        if (hipGetDevice(&dev) != hipSuccess || hipDeviceGetAttribute(&cus, hipDeviceAttributeMultiprocessorCount, dev) != hipSuccess) { grid = -1; return; }
        if (hipFuncSetAttribute((const void*)mk_fwd, hipFuncAttributeMaxDynamicSharedMemorySize, LDS_BYTES) != hipSuccess) { fprintf(stderr, "kernel_launch: hipFuncSetAttribute failed\n"); grid = -1; return; }
        if (hipOccupancyMaxActiveBlocksPerMultiprocessor(&per_cu, (const void*)mk_fwd, NTHR, LDS_BYTES) != hipSuccess || per_cu < 1) { fprintf(stderr, "kernel_launch: occupancy query says %d\n", per_cu); per_cu = 1; }
        (void)hipGetLastError();
        grid = cus * per_cu;
        fprintf(stderr, "kernel_launch: grid %d (cus %d x %d), ws %zu\n", grid, cus, per_cu, ws_size);
    }
    if (grid < 0) return;
#ifdef DBG_POISON
    (void)hipMemsetAsync(d_ws, 0xAA, WS_END, stream); (void)hipMemsetAsync(d_out, 0xAA, (size_t)out_size * 4, stream);
#endif
    (void)hipMemsetAsync((char*)d_ws + WS_BAR, 0, WS_CTL_BYTES, stream);
    Args a{};
    for (int i = 0; i < 16; ++i) a.in[i] = (const float*)d_in[i];
    a.out = (float*)d_out; a.ws = (unsigned char*)d_ws;
#if MK_SPLIT
    for (int p = 0; p < NPHASE; ++p) {
        a.ph_lo = p; a.ph_hi = p + 1; void* kargs[] = {&a};
        hipError_t e = hipLaunchCooperativeKernel((const void*)mk_fwd, dim3(grid), dim3(NTHR), kargs, LDS_BYTES, stream);
        if (e != hipSuccess) { fprintf(stderr, "cooperative launch %d failed: %s (grid %d)\n", p, hipGetErrorString(e), grid); break; }
    }
#else
    a.ph_lo = 0; a.ph_hi = NPHASE; void* kargs[] = {&a};
    hipError_t e = hipLaunchCooperativeKernel((const void*)mk_fwd, dim3(grid), dim3(NTHR), kargs, LDS_BYTES, stream);
    if (e != hipSuccess) fprintf(stderr, "cooperative launch failed: %s (grid %d)\n", hipGetErrorString(e), grid);
#endif
}
```
